# Optimizing an MI355X kernel written in HIP

```python
import math
import jax, jax.numpy as jnp
from jax import lax
import numpy as np

D_MODEL = 1024
BATCH = 8
SEQ = 2048
DEPTH = 4

GRID_W = 64
CTX_LEN = 256
Q_BLOCK = 128
HEAD_DIM = 64
ROPE_BASE = 10000.0
GQA_Q_HEADS = 8
GQA_KV_HEADS = 2
GQA_GROUP = GQA_Q_HEADS // GQA_KV_HEADS
DIFF_HEADS = 4
DIFF_V_DIM = 2 * HEAD_DIM
GQA_Q_W = GQA_Q_HEADS * HEAD_DIM
GQA_KV_W = GQA_KV_HEADS * HEAD_DIM
DIFF_QK_W = DIFF_HEADS * 2 * HEAD_DIM
DIFF_V_W = DIFF_HEADS * DIFF_V_DIM
ATTN_IN_W = GQA_Q_W + 2 * GQA_KV_W + 2 * DIFF_QK_W + DIFF_V_W
ATTN_OUT_W = GQA_Q_W + DIFF_V_W
ATTN_SPLITS = (GQA_Q_W, GQA_Q_W + GQA_KV_W, GQA_Q_W + 2 * GQA_KV_W,
               GQA_Q_W + 2 * GQA_KV_W + DIFF_QK_W, GQA_Q_W + 2 * GQA_KV_W + 2 * DIFF_QK_W)
SSM_GROUP_CH = 16
SSM_GROUPS = D_MODEL // SSM_GROUP_CH
SSM_STATE = 64
SSM_DT_MIN = 0.001
SSM_DT_MAX = 0.1
MOE_GROUPS = 4
MOE_EXPERTS_PER_GROUP = 8
MOE_EXPERTS = MOE_GROUPS * MOE_EXPERTS_PER_GROUP
MOE_TOP_K = 2
MOE_HIDDEN = D_MODEL // 4
RMS_EPS = 1e-6

kernel_name = 'hybrid_gqa_diffattn_s5_hmoe_dit'


def rms_norm(x, g):
    xf = x.astype(jnp.float32)
    y = xf * lax.rsqrt(jnp.mean(xf * xf, axis=-1, keepdims=True) + RMS_EPS)
    return (y * g.astype(jnp.float32)).astype(x.dtype)


def modulate(x, shift, scale):
    return x * (1 + scale) + shift


def axial_rope_tables(seq_len, dtype):
    n_rows = seq_len // GRID_W
    rows = jnp.repeat(jnp.arange(n_rows, dtype=jnp.float32), GRID_W)
    cols = jnp.tile(jnp.arange(GRID_W, dtype=jnp.float32), n_rows)
    half = HEAD_DIM // 2
    inv = 1.0 / (ROPE_BASE ** (jnp.arange(0, half, 2, dtype=jnp.float32) / half))
    ang_r = rows[:, None] * inv
    ang_c = cols[:, None] * inv
    ang = jnp.concatenate([ang_r, ang_r, ang_c, ang_c], axis=-1)
    return jnp.cos(ang).astype(dtype)[None, :, None, :], jnp.sin(ang).astype(dtype)[None, :, None, :]


def apply_rope(x, cos, sin):
    xs = x.reshape(x.shape[:-1] + (2, 2, HEAD_DIM // 4))
    rot = jnp.stack([-xs[..., 1, :], xs[..., 0, :]], axis=-2).reshape(x.shape)
    return x * cos + rot * sin


def sweep_query_blocks(fn, qs):
    b, lq = qs[0].shape[:2]
    nb = lq // Q_BLOCK
    blocks = tuple(jnp.moveaxis(q.reshape((b, nb, Q_BLOCK) + q.shape[2:]), 1, 0) for q in qs)
    out = lax.map(fn, blocks)
    return jnp.moveaxis(out, 0, 1).reshape((b, lq) + out.shape[3:])


def gqa_attend(q, k, v):
    scale = HEAD_DIM ** -0.5

    def blk(qs):
        (qb,) = qs
        s = jnp.einsum('bqhgd,bkhd->bhgqk', qb, k, preferred_element_type=jnp.float32) * scale
        p = jax.nn.softmax(s, axis=-1).astype(v.dtype)
        return jnp.einsum('bhgqk,bkhd->bqhgd', p, v)

    return sweep_query_blocks(blk, (q,))


def diff_attend(q1, q2, k1, k2, v, lam):
    scale = HEAD_DIM ** -0.5

    def blk(qs):
        q1b, q2b = qs
        s1 = jnp.einsum('bqhd,bkhd->bhqk', q1b, k1, preferred_element_type=jnp.float32) * scale
        s2 = jnp.einsum('bqhd,bkhd->bhqk', q2b, k2, preferred_element_type=jnp.float32) * scale
        p = jax.nn.softmax(s1, axis=-1) - lam * jax.nn.softmax(s2, axis=-1)
        return jnp.einsum('bhqk,bkhe->bqhe', p.astype(v.dtype), v)

    return sweep_query_blocks(blk, (q1, q2))


def attention_mixer(xn, cn, w_in, w_out, q_g, k_g, lq1, lk1, lq2, lk2, subln_g, lambda_init, with_ctx_out):
    bsz = xn.shape[0]

    def project(t, with_pos):
        n = t.shape[1]
        hp = t @ w_in
        qa, ka, va, qb, kb, vb = jnp.split(hp, ATTN_SPLITS, axis=-1)
        qa = rms_norm(qa.reshape(bsz, n, GQA_Q_HEADS, HEAD_DIM), q_g)
        ka = rms_norm(ka.reshape(bsz, n, GQA_KV_HEADS, HEAD_DIM), k_g)
        va = va.reshape(bsz, n, GQA_KV_HEADS, HEAD_DIM)
        qb = qb.reshape(bsz, n, 2 * DIFF_HEADS, HEAD_DIM)
        kb = kb.reshape(bsz, n, 2 * DIFF_HEADS, HEAD_DIM)
        vb = vb.reshape(bsz, n, DIFF_HEADS, DIFF_V_DIM)
        if with_pos:
            cos, sin = axial_rope_tables(n, t.dtype)
            qa, ka, qb, kb = (apply_rope(a, cos, sin) for a in (qa, ka, qb, kb))
        return qa, ka, va, qb, kb, vb

    lam = (jnp.exp(jnp.sum(lq1.astype(jnp.float32) * lk1.astype(jnp.float32)))
           - jnp.exp(jnp.sum(lq2.astype(jnp.float32) * lk2.astype(jnp.float32))) + lambda_init)

    def mix(qa, qb, ka, va, kb, vb):
        n = qa.shape[1]
        oa = gqa_attend(qa.reshape(bsz, n, GQA_KV_HEADS, GQA_GROUP, HEAD_DIM), ka, va)
        qb5 = qb.reshape(bsz, n, DIFF_HEADS, 2, HEAD_DIM)
        kb5 = kb.reshape(bsz, kb.shape[1], DIFF_HEADS, 2, HEAD_DIM)
        ob = diff_attend(qb5[..., 0, :], qb5[..., 1, :], kb5[..., 0, :], kb5[..., 1, :], vb, lam)
        ob = rms_norm(ob, subln_g) * (1.0 - lambda_init)
        merged = jnp.concatenate([oa.reshape(bsz, n, GQA_Q_W), ob.reshape(bsz, n, DIFF_V_W)], axis=-1)
        return merged @ w_out

    lqa, lka, lva, lqb, lkb, lvb = project(xn, True)
    cqa, cka, cva, cqb, ckb, cvb = project(cn, False)
    cat = lambda a, b: jnp.concatenate([a, b], axis=1)
    y_lat = mix(lqa, lqb, cat(cka, lka), cat(cva, lva), cat(ckb, lkb), cat(cvb, lvb))
    y_ctx = mix(cqa, cqb, cka, cva, ckb, cvb) if with_ctx_out else None
    return y_lat, y_ctx


def cmul(ar, ai, br, bi):
    return ar * br - ai * bi, ar * bi + ai * br


def lti_combine(e1, e2):
    a1r, a1i, b1r, b1i = e1
    a2r, a2i, b2r, b2i = e2
    ar, ai = cmul(a2r, a2i, a1r, a1i)
    br, bi = cmul(a2r, a2i, b1r, b1i)
    return ar, ai, br + b2r, bi + b2i


def diag_scan(lbar_re, lbar_im, bu_re, bu_im, h0, reverse):
    l = bu_re.shape[1]
    shape = (1, l) + lbar_re.shape
    elems = (jnp.broadcast_to(lbar_re, shape), jnp.broadcast_to(lbar_im, shape), bu_re, bu_im)
    a_re, a_im, s_re, s_im = lax.associative_scan(lti_combine, elems, reverse=reverse, axis=1)
    if h0 is not None:
        dr, di = cmul(a_re, a_im, h0[0], h0[1])
        s_re = s_re + dr
        s_im = s_im + di
    return s_re, s_im


def s5_direction(u_lat, u_ctx, a_re, a_im, log_dt, b_re, b_im, c_re, c_im, reverse, with_ctx_out):
    f32 = jnp.float32
    lre = jnp.minimum(a_re.astype(f32), -1e-4)
    lim = a_im.astype(f32)
    dt = jnp.exp(log_dt.astype(f32))[:, None]
    mag = jnp.exp(lre * dt)
    lbar_re = mag * jnp.cos(lim * dt)
    lbar_im = mag * jnp.sin(lim * dt)
    nr = lbar_re - 1.0
    ni = lbar_im
    den = lre * lre + lim * lim
    coef_re = (nr * lre + ni * lim) / den
    coef_im = (ni * lre - nr * lim) / den
    bb_re, bb_im = cmul(coef_re[..., None], coef_im[..., None], b_re.astype(f32), b_im.astype(f32))
    cr = c_re.astype(f32)
    ci = c_im.astype(f32)

    def drive(u):
        ug = u.reshape(u.shape[:2] + (SSM_GROUPS, SSM_GROUP_CH))
        return jnp.einsum('gpc,blgc->blgp', bb_re, ug), jnp.einsum('gpc,blgc->blgp', bb_im, ug)

    def readout(s_re, s_im):
        y = jnp.einsum('gcp,blgp->blgc', cr, s_re) - jnp.einsum('gcp,blgp->blgc', ci, s_im)
        return y.reshape(y.shape[:2] + (D_MODEL,))

    cs_re, cs_im = diag_scan(lbar_re, lbar_im, *drive(u_ctx), None, reverse)
    idx = 0 if reverse else cs_re.shape[1] - 1
    h0 = (cs_re[:, idx:idx + 1], cs_im[:, idx:idx + 1])
    ls_re, ls_im = diag_scan(lbar_re, lbar_im, *drive(u_lat), h0, reverse)
    y_lat = readout(ls_re, ls_im)
    y_ctx = readout(cs_re, cs_im) if with_ctx_out else None
    return y_lat, y_ctx


def s5_mixer(xn, cn, a_re, a_im, log_dt, b_re, b_im, c_re, c_im, d_skip, w_a, w_b, with_ctx_out):
    u = xn.astype(jnp.float32)
    uc = cn.astype(jnp.float32)
    yf, ycf = s5_direction(u, uc, a_re[0], a_im[0], log_dt[0], b_re[0], b_im[0], c_re[0], c_im[0], False, with_ctx_out)
    yb, ycb = s5_direction(u, uc, a_re[1], a_im[1], log_dt[1], b_re[1], b_im[1], c_re[1], c_im[1], True, with_ctx_out)
    d = d_skip.astype(jnp.float32)

    def out(y, uu):
        y = jax.nn.gelu(y + d * uu).astype(xn.dtype)
        return (y @ w_a) * jax.nn.sigmoid(y @ w_b)

    y_lat = out(yf + yb, u)
    y_ctx = out(ycf + ycb, uc) if with_ctx_out else None
    return y_lat, y_ctx


def moe_tokens(xt, gw, gb, rw, rb, w_gate, w_up, w_down):
    f32 = jnp.float32
    xf = xt.astype(f32)
    g_logits = xf @ gw.astype(f32) + gb.astype(f32)
    g_prob = jax.nn.softmax(g_logits, axis=-1)
    _, g_idx = lax.top_k(g_logits, 1)
    g_onehot = jax.nn.one_hot(g_idx[:, 0], MOE_GROUPS, dtype=f32)
    p_group = jnp.sum(g_prob * g_onehot, axis=-1, keepdims=True)
    e_logits = jnp.einsum('sd,gde->sge', xf, rw.astype(f32)) + rb.astype(f32)
    e_sel = jnp.einsum('sge,sg->se', e_logits, g_onehot)
    e_val, e_idx = lax.top_k(e_sel, MOE_TOP_K)
    w_top = jax.nn.softmax(e_val, axis=-1) * p_group
    expert = g_idx * MOE_EXPERTS_PER_GROUP + e_idx
    combine = jnp.sum(jax.nn.one_hot(expert, MOE_EXPERTS, dtype=f32) * w_top[..., None], axis=1)
    hid = jax.nn.silu(jnp.einsum('sd,edf->sef', xt, w_gate)) * jnp.einsum('sd,edf->sef', xt, w_up)
    hid = hid * combine[..., None].astype(hid.dtype)
    return jnp.einsum('sef,efd->sd', hid, w_down)


def hier_moe(x, gw, gb, rw, rb, w_gate, w_up, w_down):
    return lax.map(lambda xb: moe_tokens(xb, gw, gb, rw, rb, w_gate, w_up, w_down), x)


def setup_inputs(seed: int = 0) -> dict:
    key = jax.random.key(seed)
    ks = iter(jax.random.split(key, 48))
    f32 = jnp.float32
    D = D_MODEL
    n_attn = (DEPTH + 1) // 2
    n_ssm = DEPTH // 2

    def nrm(shape, std):
        return jax.random.normal(next(ks), shape, f32) * std

    def gain(shape):
        return 1.0 + nrm(shape, 0.02)

    return {
        'x': nrm((BATCH, SEQ, D), 1.0),
        'c': nrm((BATCH, D), 1.0),
        'ctx': nrm((BATCH, CTX_LEN, D), 1.0),
        'c_ctx': nrm((D,), 1.0),
        'mod_w': nrm((DEPTH, D, 6 * D), 0.5 * D ** -0.5),
        'mod_b': nrm((DEPTH, 6 * D), 0.02),
        'norm1_g': gain((DEPTH, D)),
        'norm2_g': gain((DEPTH, D)),
        'final_g': gain((D,)),
        'attn_w_in': nrm((n_attn, D, ATTN_IN_W), D ** -0.5),
        'attn_w_out': nrm((n_attn, ATTN_OUT_W, D), ATTN_OUT_W ** -0.5),
        'attn_q_norm_g': gain((n_attn, HEAD_DIM)),
        'attn_k_norm_g': gain((n_attn, HEAD_DIM)),
        'diff_lambda_q1': nrm((n_attn, HEAD_DIM), 0.1),
        'diff_lambda_k1': nrm((n_attn, HEAD_DIM), 0.1),
        'diff_lambda_q2': nrm((n_attn, HEAD_DIM), 0.1),
        'diff_lambda_k2': nrm((n_attn, HEAD_DIM), 0.1),
        'diff_subln_g': gain((n_attn, DIFF_V_DIM)),
        'ssm_a_re': -0.5 + nrm((n_ssm, 2, SSM_GROUPS, SSM_STATE), 0.01),
        'ssm_a_im': math.pi * jnp.arange(SSM_STATE, dtype=f32) + nrm((n_ssm, 2, SSM_GROUPS, SSM_STATE), 0.01),
        'ssm_log_dt': jax.random.uniform(next(ks), (n_ssm, 2, SSM_GROUPS), f32,
                                         math.log(SSM_DT_MIN), math.log(SSM_DT_MAX)),
        'ssm_b_re': nrm((n_ssm, 2, SSM_GROUPS, SSM_STATE, SSM_GROUP_CH), (2 * SSM_GROUP_CH) ** -0.5),
        'ssm_b_im': nrm((n_ssm, 2, SSM_GROUPS, SSM_STATE, SSM_GROUP_CH), (2 * SSM_GROUP_CH) ** -0.5),
        'ssm_c_re': nrm((n_ssm, 2, SSM_GROUPS, SSM_GROUP_CH, SSM_STATE), (2 * SSM_STATE) ** -0.5),
        'ssm_c_im': nrm((n_ssm, 2, SSM_GROUPS, SSM_GROUP_CH, SSM_STATE), (2 * SSM_STATE) ** -0.5),
        'ssm_d': nrm((n_ssm, D), 1.0),
        'ssm_glu_w_a': nrm((n_ssm, D, D), D ** -0.5),
        'ssm_glu_w_b': nrm((n_ssm, D, D), D ** -0.5),
        'moe_group_w': nrm((DEPTH, D, MOE_GROUPS), D ** -0.5),
        'moe_group_b': nrm((DEPTH, MOE_GROUPS), 0.01),
        'moe_router_w': nrm((DEPTH, MOE_GROUPS, D, MOE_EXPERTS_PER_GROUP), D ** -0.5),
        'moe_router_b': nrm((DEPTH, MOE_GROUPS, MOE_EXPERTS_PER_GROUP), 0.01),
        'moe_w_gate': nrm((DEPTH, MOE_EXPERTS, D, MOE_HIDDEN), D ** -0.5),
        'moe_w_up': nrm((DEPTH, MOE_EXPERTS, D, MOE_HIDDEN), D ** -0.5),
        'moe_w_down': nrm((DEPTH, MOE_EXPERTS, MOE_HIDDEN, D), MOE_HIDDEN ** -0.5),
    }


def reference(x, c, ctx, c_ctx, mod_w, mod_b, norm1_g, norm2_g, final_g,
              attn_w_in, attn_w_out, attn_q_norm_g, attn_k_norm_g,
              diff_lambda_q1, diff_lambda_k1, diff_lambda_q2, diff_lambda_k2, diff_subln_g,
              ssm_a_re, ssm_a_im, ssm_log_dt, ssm_b_re, ssm_b_im, ssm_c_re, ssm_c_im, ssm_d,
              ssm_glu_w_a, ssm_glu_w_b,
              moe_group_w, moe_group_b, moe_router_w, moe_router_b, moe_w_gate, moe_w_up, moe_w_down):
    h, hc = x, ctx
    for layer in range(DEPTH):
        last = layer == DEPTH - 1
        m = [t[:, None, :] for t in jnp.split(jax.nn.silu(c) @ mod_w[layer] + mod_b[layer], 6, axis=-1)]
        mc = [t[None, None, :] for t in jnp.split(jax.nn.silu(c_ctx) @ mod_w[layer] + mod_b[layer], 6, axis=-1)]
        xn = modulate(rms_norm(h, norm1_g[layer]), m[0], m[1])
        cn = modulate(rms_norm(hc, norm1_g[layer]), mc[0], mc[1])
        i = layer // 2
        if layer % 2 == 0:
            lambda_init = 0.8 - 0.6 * math.exp(-0.3 * layer)
            y, yc = attention_mixer(xn, cn, attn_w_in[i], attn_w_out[i], attn_q_norm_g[i], attn_k_norm_g[i],
                                    diff_lambda_q1[i], diff_lambda_k1[i], diff_lambda_q2[i], diff_lambda_k2[i],
                                    diff_subln_g[i], lambda_init, not last)
        else:
            y, yc = s5_mixer(xn, cn, ssm_a_re[i], ssm_a_im[i], ssm_log_dt[i], ssm_b_re[i], ssm_b_im[i],
                             ssm_c_re[i], ssm_c_im[i], ssm_d[i], ssm_glu_w_a[i], ssm_glu_w_b[i], not last)
        moe_p = (moe_group_w[layer], moe_group_b[layer], moe_router_w[layer], moe_router_b[layer],
                 moe_w_gate[layer], moe_w_up[layer], moe_w_down[layer])
        h = h + m[2] * y
        h = h + m[5] * hier_moe(modulate(rms_norm(h, norm2_g[layer]), m[3], m[4]), *moe_p)
        if not last:
            hc = hc + mc[2] * yc
            hc = hc + mc[5] * hier_moe(modulate(rms_norm(hc, norm2_g[layer]), mc[3], mc[4]), *moe_p)
    return rms_norm(h, final_g)
```

```cpp
#include <hip/hip_runtime.h>
#include <cstdio>
#include <cstdint>
namespace nv {
constexpr int D = 1024, NLAT = 16384, NCTX = 2048, NROWS = 18432, SEQ = 2048, CTX = 256;

__device__ __forceinline__ float wsum(float v) {
#pragma unroll
    for (int o = 1; o < 64; o <<= 1) v += __shfl_xor(v, o);
    return v;
}
__device__ __forceinline__ float bsum256(float v, float* red) {
    v = wsum(v);
    __syncthreads();
    if ((threadIdx.x & 63) == 0) red[threadIdx.x >> 6] = v;
    __syncthreads();
    return red[0] + red[1] + red[2] + red[3];
}
__device__ __forceinline__ int mrow_of(int row) { return row < NLAT ? (row >> 11) : 8; }

__global__ void __launch_bounds__(256) k_mod(const float* c, const float* c_ctx, const float* mod_w, const float* mod_b, float* modv) {
    __shared__ float s[9 * 1024];
    for (int i = threadIdx.x; i < 9 * 1024; i += 256) { int r = i >> 10, k = i & 1023; float v = r < 8 ? c[r * 1024 + k] : c_ctx[k]; s[i] = v / (1.f + expf(-v)); }
    __syncthreads();
    int col = blockIdx.x * 256 + threadIdx.x;
    int l = col / 6144, j = col % 6144;
    float a0 = 0, a1 = 0, a2 = 0, a3 = 0, a4 = 0, a5 = 0, a6 = 0, a7 = 0, a8 = 0;
    const float* w = mod_w + (size_t)l * 1024 * 6144 + j;
    for (int k = 0; k < 1024; ++k) {
        float wv = w[(size_t)k * 6144];
        a0 += s[k] * wv; a1 += s[1024 + k] * wv; a2 += s[2048 + k] * wv; a3 += s[3072 + k] * wv; a4 += s[4096 + k] * wv;
        a5 += s[5120 + k] * wv; a6 += s[6144 + k] * wv; a7 += s[7168 + k] * wv; a8 += s[8192 + k] * wv;
    }
    float b = mod_b[l * 6144 + j];
    float* o = modv + (size_t)l * 9 * 6144 + j;
    o[0] = a0 + b; o[6144] = a1 + b; o[2 * 6144] = a2 + b; o[3 * 6144] = a3 + b; o[4 * 6144] = a4 + b; o[5 * 6144] = a5 + b; o[6 * 6144] = a6 + b; o[7 * 6144] = a7 + b; o[8 * 6144] = a8 + b;
}

__global__ void __launch_bounds__(256) k_norm_mod(const float* h, const float* g, const float* modl, int shift_i, int scale_i, float* out) {
    __shared__ float red[4];
    int row = blockIdx.x, mr = mrow_of(row);
    float x[4], ss = 0;
#pragma unroll
    for (int i = 0; i < 4; ++i) { x[i] = h[(size_t)row * D + threadIdx.x + 256 * i]; ss += x[i] * x[i]; }
    ss = bsum256(ss, red);
    float r = rsqrtf(ss * (1.f / D) + 1e-6f);
#pragma unroll
    for (int i = 0; i < 4; ++i) { int c = threadIdx.x + 256 * i; float y = x[i] * r * g[c];
        if (shift_i >= 0) y = y * (1.f + modl[mr * 6144 + scale_i * 1024 + c]) + modl[mr * 6144 + shift_i * 1024 + c];
        out[(size_t)row * D + c] = y; }
}

__global__ void __launch_bounds__(256) k_sgemm(const float* A, const float* B, float* C, int K, int lda, int ldb, int ldc) {
    __shared__ float As[16][68], Bs[16][64];
    int tid = threadIdx.x, tx = tid & 15, ty = tid >> 4;
    int m0 = blockIdx.y * 64, n0 = blockIdx.x * 64;
    float acc[4][4];
#pragma unroll
    for (int i = 0; i < 4; ++i)
#pragma unroll
        for (int j = 0; j < 4; ++j) acc[i][j] = 0.f;
    for (int k0 = 0; k0 < K; k0 += 16) {
#pragma unroll
        for (int i = 0; i < 4; ++i) { int idx = tid + 256 * i; int m = idx >> 4, k = idx & 15; As[k][m] = A[(size_t)(m0 + m) * lda + k0 + k]; }
#pragma unroll
        for (int i = 0; i < 4; ++i) { int idx = tid + 256 * i; int k = idx >> 6, n = idx & 63; Bs[k][n] = B[(size_t)(k0 + k) * ldb + n0 + n]; }
        __syncthreads();
#pragma unroll
        for (int k = 0; k < 16; ++k) {
            float a[4], b[4];
#pragma unroll
            for (int i = 0; i < 4; ++i) { a[i] = As[k][ty * 4 + i]; b[i] = Bs[k][tx * 4 + i]; }
#pragma unroll
            for (int i = 0; i < 4; ++i)
#pragma unroll
                for (int j = 0; j < 4; ++j) acc[i][j] += a[i] * b[j];
        }
        __syncthreads();
    }
#pragma unroll
    for (int i = 0; i < 4; ++i)
#pragma unroll
        for (int j = 0; j < 4; ++j) C[(size_t)(m0 + ty * 4 + i) * ldc + n0 + tx * 4 + j] = acc[i][j];
}

__global__ void __launch_bounds__(64) k_qknorm_rope(float* hp, const float* qg, const float* kg) {
    int row = blockIdx.x / 26, s = blockIdx.x % 26, hs = s < 10 ? s : s + 2, d = threadIdx.x;
    float* p = hp + (size_t)row * 2304 + hs * 64;
    float x = p[d];
    if (hs < 10) { float ss = wsum(x * x); float r = rsqrtf(ss * (1.f / 64.f) + 1e-6f); x = x * r * (hs < 8 ? qg[d] : kg[d]); }
    if (row < NLAT) {
        int t = row & 2047; int sec = d >> 5, i = d & 15; float pos = sec == 0 ? (float)(t >> 6) : (float)(t & 63);
        float inv = powf(10000.f, -(float)i / 16.f); float ang = pos * inv; float cs = cosf(ang), sn = sinf(ang);
        float partner = __shfl(x, d ^ 16);
        float rot = ((d & 31) < 16) ? -partner : partner;
        x = x * cs + rot * sn;
    }
    p[d] = x;
}

template <int VD> __global__ void __launch_bounds__(256) k_attn(const float* hp, float* merged, float* o12, int is_ctx) {
    extern __shared__ float sm[];
    const int nk = is_ctx ? 256 : 2304, nqt = is_ctx ? 16 : 128;
    float* S = sm;
    float* Q = sm + 16 * 2304;
    int bid = blockIdx.x; int qt = bid % nqt; int vh8 = (bid / nqt) % 8; int b = bid / (nqt * 8);
    int vh = VD == 64 ? vh8 : 8 + vh8;
    int qcol, kcol, vcol;
    if (VD == 64) { qcol = 64 * vh; kcol = 512 + 64 * (vh >> 2); vcol = 640 + 64 * (vh >> 2); }
    else { int hd = vh8 >> 1, w = vh8 & 1; qcol = 768 + (2 * hd + w) * 64; kcol = 1280 + (2 * hd + w) * 64; vcol = 1792 + 128 * hd; }
    int qrow0 = is_ctx ? NLAT + b * 256 + qt * 16 : b * 2048 + qt * 16;
    int tid = threadIdx.x;
    for (int i = tid; i < 16 * 64; i += 256) Q[i] = hp[(size_t)(qrow0 + (i >> 6)) * 2304 + qcol + (i & 63)] * 0.125f;
    __syncthreads();
    for (int j = tid; j < nk; j += 256) {
        int krow = is_ctx ? NLAT + b * 256 + j : (j < 256 ? NLAT + b * 256 + j : b * 2048 + j - 256);
        const float4* kp = (const float4*)(hp + (size_t)krow * 2304 + kcol);
        float4 kr[16];
#pragma unroll
        for (int i = 0; i < 16; ++i) kr[i] = kp[i];
        for (int q = 0; q < 16; ++q) {
            const float4* qp = (const float4*)(Q + q * 64); float a = 0;
#pragma unroll
            for (int i = 0; i < 16; ++i) { float4 qq = qp[i]; a += qq.x * kr[i].x + qq.y * kr[i].y + qq.z * kr[i].z + qq.w * kr[i].w; }
            S[q * nk + j] = a;
        }
    }
    __syncthreads();
    { int q = tid >> 4, l = tid & 15; float m = -1e30f;
      for (int j = l; j < nk; j += 16) m = fmaxf(m, S[q * nk + j]);
#pragma unroll
      for (int o = 1; o < 16; o <<= 1) m = fmaxf(m, __shfl_xor(m, o));
      float sum = 0;
      for (int j = l; j < nk; j += 16) { float e = expf(S[q * nk + j] - m); S[q * nk + j] = e; sum += e; }
#pragma unroll
      for (int o = 1; o < 16; o <<= 1) sum += __shfl_xor(sum, o);
      float inv = 1.f / sum;
      for (int j = l; j < nk; j += 16) S[q * nk + j] *= inv; }
    __syncthreads();
    constexpr int QG = 256 / VD, NQ = 16 / QG;
    int d = tid % VD, qg = tid / VD;
    float acc[NQ];
#pragma unroll
    for (int i = 0; i < NQ; ++i) acc[i] = 0.f;
    for (int j = 0; j < nk; ++j) {
        int krow = is_ctx ? NLAT + b * 256 + j : (j < 256 ? NLAT + b * 256 + j : b * 2048 + j - 256);
        float v = hp[(size_t)krow * 2304 + vcol + d];
#pragma unroll
        for (int i = 0; i < NQ; ++i) acc[i] += S[(qg * NQ + i) * nk + j] * v;
    }
#pragma unroll
    for (int i = 0; i < NQ; ++i) { int row = qrow0 + qg * NQ + i;
        if (VD == 64) merged[(size_t)row * D + 64 * vh + d] = acc[i];
        else o12[(size_t)row * 1024 + vh8 * 128 + d] = acc[i]; }
}

__global__ void __launch_bounds__(128) k_diffcombine(const float* o12, float* merged, const float* lq1, const float* lk1, const float* lq2, const float* lk2, const float* subg, float lambda_init) {
    __shared__ float red[2];
    int row = blockIdx.x >> 2, hd = blockIdx.x & 3, d = threadIdx.x;
    float a = 0, bq = 0;
    if (d < 64) { a = lq1[d] * lk1[d]; bq = lq2[d] * lk2[d]; }
    a = wsum(a); bq = wsum(bq);
    __syncthreads(); if (d == 0) { red[0] = a; red[1] = bq; } __syncthreads();
    float lam = expf(red[0]) - expf(red[1]) + lambda_init;
    __syncthreads();
    float o = o12[(size_t)row * 1024 + hd * 256 + d] - lam * o12[(size_t)row * 1024 + hd * 256 + 128 + d];
    float ss = wsum(o * o);
    if ((d & 63) == 0) red[d >> 6] = ss;
    __syncthreads();
    float r = rsqrtf((red[0] + red[1]) * (1.f / 128.f) + 1e-6f);
    merged[(size_t)row * D + 512 + hd * 128 + d] = o * r * subg[d] * (1.f - lambda_init);
}

__global__ void __launch_bounds__(256) k_resid(float* h, const float* ya, const float* yb, const float* modl, int gi, int mode) {
    int row = blockIdx.x, mr = mrow_of(row);
#pragma unroll
    for (int i = 0; i < 4; ++i) { int c = threadIdx.x + 256 * i; float y = ya[(size_t)row * D + c];
        if (mode) { float z = yb[(size_t)row * D + c]; y = y / (1.f + expf(-z)); }
        h[(size_t)row * D + c] += modl[mr * 6144 + gi * 1024 + c] * y; }
}

__global__ void __launch_bounds__(64) k_ssm(const float* xn, const float* a_re, const float* a_im, const float* log_dt, const float* b_re, const float* b_im,
                                            const float* c_re, const float* c_im, float* yd) {
    __shared__ float sre[64], sim[64];
    int bid = blockIdx.x; int dir = bid & 1, g = (bid >> 1) & 63, b = bid >> 7; int p = threadIdx.x;
    size_t gp = (size_t)(dir * 64 + g) * 64 + p;
    float lre = fminf(a_re[gp], -1e-4f), lim = a_im[gp], dt = expf(log_dt[dir * 64 + g]);
    float mag = expf(lre * dt), lbr = mag * cosf(lim * dt), lbi = mag * sinf(lim * dt);
    float nr = lbr - 1.f, ni = lbi, den = lre * lre + lim * lim;
    float cfr = (nr * lre + ni * lim) / den, cfi = (ni * lre - nr * lim) / den;
    float bbr[16], bbi[16];
#pragma unroll
    for (int c = 0; c < 16; ++c) { float br = b_re[gp * 16 + c], bi = b_im[gp * 16 + c]; bbr[c] = cfr * br - cfi * bi; bbi[c] = cfr * bi + cfi * br; }
    float cr[64], ci[64];
    { int c = p & 15; size_t base = ((size_t)(dir * 64 + g) * 16 + c) * 64;
#pragma unroll
      for (int q = 0; q < 64; ++q) { cr[q] = c_re[base + q]; ci[q] = c_im[base + q]; } }
    float s_r = 0.f, s_i = 0.f;
    float* yo = yd + (size_t)dir * NROWS * D;
    for (int idx = 0; idx < 2304; ++idx) {
        int row;
        if (dir == 0) row = idx < 256 ? NLAT + b * 256 + idx : b * 2048 + idx - 256;
        else row = idx < 256 ? NLAT + b * 256 + (255 - idx) : b * 2048 + (2047 - (idx - 256));
        const float4* up = (const float4*)(xn + (size_t)row * D + 16 * g);
        float4 u0 = up[0], u1 = up[1], u2 = up[2], u3 = up[3];
        float u[16] = {u0.x, u0.y, u0.z, u0.w, u1.x, u1.y, u1.z, u1.w, u2.x, u2.y, u2.z, u2.w, u3.x, u3.y, u3.z, u3.w};
        float br = 0, bi = 0;
#pragma unroll
        for (int c = 0; c < 16; ++c) { br += bbr[c] * u[c]; bi += bbi[c] * u[c]; }
        float nr2 = lbr * s_r - lbi * s_i + br, ni2 = lbr * s_i + lbi * s_r + bi; s_r = nr2; s_i = ni2;
        __syncthreads();
        sre[p] = s_r; sim[p] = s_i;
        __syncthreads();
        if (p < 16) { float y = 0;
#pragma unroll
            for (int q = 0; q < 64; ++q) y += cr[q] * sre[q] - ci[q] * sim[q];
            yo[(size_t)row * D + 16 * g + p] = y; }
    }
}
__device__ __forceinline__ float gelu_tanh(float x) { float u = 0.7978845608028654f * (x + 0.044715f * x * x * x); return 0.5f * x * (1.f + tanhf(u)); }
__global__ void __launch_bounds__(256) k_ssm_out(const float* yd, const float* xn, const float* dskip, float* gout) {
    int row = blockIdx.x;
#pragma unroll
    for (int i = 0; i < 4; ++i) { int c = threadIdx.x + 256 * i; size_t o = (size_t)row * D + c;
        float y = yd[o] + yd[(size_t)NROWS * D + o] + dskip[c] * xn[o]; gout[o] = gelu_tanh(y); }
}

__global__ void __launch_bounds__(256) k_moe(float* h, const float* g2, const float* modl, const float* gw, const float* gb, const float* rw, const float* rb,
                                             const float* wg, const float* wu, const float* wd) {
    __shared__ float xm[1024], hid[256], lg[36], red[4]; __shared__ int sel[3]; __shared__ float wts[2];
    int row = blockIdx.x, mr = mrow_of(row), tid = threadIdx.x;
    float x[4], ss = 0;
#pragma unroll
    for (int i = 0; i < 4; ++i) { x[i] = h[(size_t)row * D + tid + 256 * i]; ss += x[i] * x[i]; }
    ss = bsum256(ss, red);
    float r = rsqrtf(ss * (1.f / D) + 1e-6f);
#pragma unroll
    for (int i = 0; i < 4; ++i) { int c = tid + 256 * i; xm[c] = x[i] * r * g2[c] * (1.f + modl[mr * 6144 + 4 * 1024 + c]) + modl[mr * 6144 + 3 * 1024 + c]; }
    __syncthreads();
    if (tid < 36) { float a = 0;
        if (tid < 4) { for (int d = 0; d < 1024; ++d) a += xm[d] * gw[d * 4 + tid]; a += gb[tid]; }
        else { int o = tid - 4, gg = o >> 3, e = o & 7; for (int d = 0; d < 1024; ++d) a += xm[d] * rw[((size_t)gg * 1024 + d) * 8 + e]; a += rb[o]; }
        lg[tid] = a; }
    __syncthreads();
    if (tid == 0) {
        int gi = 0; float gm = lg[0];
        for (int i = 1; i < 4; ++i) if (lg[i] > gm) { gm = lg[i]; gi = i; }
        float se = 0; for (int i = 0; i < 4; ++i) se += expf(lg[i] - gm);
        float pg = 1.f / se;
        const float* el = lg + 4 + gi * 8;
        int e1 = 0; float v1 = el[0];
        for (int i = 1; i < 8; ++i) if (el[i] > v1) { v1 = el[i]; e1 = i; }
        int e2 = -1; float v2 = -3.4e38f;
        for (int i = 0; i < 8; ++i) if (i != e1 && el[i] > v2) { v2 = el[i]; e2 = i; }
        float ex = expf(v2 - v1); float w1 = 1.f / (1.f + ex), w2 = ex / (1.f + ex);
        sel[0] = gi * 8 + e1; sel[1] = gi * 8 + e2; wts[0] = w1 * pg; wts[1] = w2 * pg;
    }
    __syncthreads();
    float acc[4] = {0.f, 0.f, 0.f, 0.f};
    for (int k = 0; k < 2; ++k) {
        int e = sel[k]; float wk = wts[k];
        const float* pg_ = wg + (size_t)e * 1024 * 256 + tid; const float* pu_ = wu + (size_t)e * 1024 * 256 + tid;
        float ga = 0, ua = 0;
        for (int d = 0; d < 1024; ++d) { float xv = xm[d]; ga += xv * pg_[(size_t)d * 256]; ua += xv * pu_[(size_t)d * 256]; }
        __syncthreads();
        hid[tid] = ga / (1.f + expf(-ga)) * ua * wk;
        __syncthreads();
        const float* pd_ = wd + (size_t)e * 256 * 1024 + tid;
        for (int f = 0; f < 256; ++f) { float hv = hid[f];
#pragma unroll
            for (int i = 0; i < 4; ++i) acc[i] += hv * pd_[(size_t)f * 1024 + 256 * i]; }
    }
#pragma unroll
    for (int i = 0; i < 4; ++i) { int c = tid + 256 * i; h[(size_t)row * D + c] += modl[mr * 6144 + 5 * 1024 + c] * acc[i]; }
}
}
static void naive_forward(void* const* d_in, float* out, unsigned char* ws, hipStream_t st) {
    using namespace nv;
    const float* x = (const float*)d_in[0]; const float* c = (const float*)d_in[1]; const float* ctx = (const float*)d_in[2]; const float* c_ctx = (const float*)d_in[3];
    const float* mod_w = (const float*)d_in[4]; const float* mod_b = (const float*)d_in[5]; const float* n1g = (const float*)d_in[6]; const float* n2g = (const float*)d_in[7];
    const float* fing = (const float*)d_in[8]; const float* w_in = (const float*)d_in[9]; const float* w_out = (const float*)d_in[10];
    const float* qg = (const float*)d_in[11]; const float* kg = (const float*)d_in[12];
    const float* lq1 = (const float*)d_in[13]; const float* lk1 = (const float*)d_in[14]; const float* lq2 = (const float*)d_in[15]; const float* lk2 = (const float*)d_in[16];
    const float* subg = (const float*)d_in[17];
    const float* a_re = (const float*)d_in[18]; const float* a_im = (const float*)d_in[19]; const float* log_dt = (const float*)d_in[20];
    const float* b_re = (const float*)d_in[21]; const float* b_im = (const float*)d_in[22]; const float* c_re = (const float*)d_in[23]; const float* c_im = (const float*)d_in[24];
    const float* ssm_d = (const float*)d_in[25]; const float* glu_a = (const float*)d_in[26]; const float* glu_b = (const float*)d_in[27];
    const float* mgw = (const float*)d_in[28]; const float* mgb = (const float*)d_in[29]; const float* mrw = (const float*)d_in[30]; const float* mrb = (const float*)d_in[31];
    const float* wg = (const float*)d_in[32]; const float* wu = (const float*)d_in[33]; const float* wd = (const float*)d_in[34];
    const size_t MiB = 1u << 20;
    float* modv = (float*)(ws + 0);
    float* h = (float*)(ws + 1 * MiB);
    float* xn = (float*)(ws + 73 * MiB);
    float* merged = (float*)(ws + 145 * MiB);
    float* hp = (float*)(ws + 217 * MiB);
    float* o12 = (float*)(ws + 379 * MiB);
    static bool attr = false;
    if (!attr) { hipFuncSetAttribute((const void*)k_attn<64>, hipFuncAttributeMaxDynamicSharedMemorySize, 151552); hipFuncSetAttribute((const void*)k_attn<128>, hipFuncAttributeMaxDynamicSharedMemorySize, 151552); attr = true; }
    k_mod<<<96, 256, 0, st>>>(c, c_ctx, mod_w, mod_b, modv);
    hipMemcpyAsync(h, x, (size_t)NLAT * D * 4, hipMemcpyDeviceToDevice, st);
    hipMemcpyAsync(h + (size_t)NLAT * D, ctx, (size_t)NCTX * D * 4, hipMemcpyDeviceToDevice, st);
    for (int layer = 0; layer < 4; ++layer) {
        const bool last = layer == 3; const int i = layer / 2; const int nrows = last ? NLAT : NROWS;
        const float* modl = modv + (size_t)layer * 9 * 6144;
        k_norm_mod<<<NROWS, 256, 0, st>>>(h, n1g + layer * D, modl, 0, 1, xn);
        if ((layer & 1) == 0) {
            const float lambda_init = 0.8f - 0.6f * expf(-0.3f * (float)layer);
            k_sgemm<<<dim3(2304 / 64, NROWS / 64), 256, 0, st>>>(xn, w_in + (size_t)i * D * 2304, hp, D, D, 2304, 2304);
            k_qknorm_rope<<<NROWS * 26, 64, 0, st>>>(hp, qg + i * 64, kg + i * 64);
            k_attn<64><<<8 * 8 * 128, 256, 151552, st>>>(hp, merged, o12, 0);
            k_attn<128><<<8 * 8 * 128, 256, 151552, st>>>(hp, merged, o12, 0);
            k_attn<64><<<8 * 8 * 16, 256, 151552, st>>>(hp, merged, o12, 1);
            k_attn<128><<<8 * 8 * 16, 256, 151552, st>>>(hp, merged, o12, 1);
            k_diffcombine<<<NROWS * 4, 128, 0, st>>>(o12, merged, lq1 + i * 64, lk1 + i * 64, lq2 + i * 64, lk2 + i * 64, subg + i * 128, lambda_init);
            k_sgemm<<<dim3(D / 64, NROWS / 64), 256, 0, st>>>(merged, w_out + (size_t)i * D * D, xn, D, D, D, D);
            k_resid<<<NROWS, 256, 0, st>>>(h, xn, nullptr, modl, 2, 0);
        } else {
            float* yd = hp;
            k_ssm<<<8 * 64 * 2, 64, 0, st>>>(xn, a_re + (size_t)i * 8192, a_im + (size_t)i * 8192, log_dt + i * 128, b_re + (size_t)i * 131072, b_im + (size_t)i * 131072,
                                            c_re + (size_t)i * 131072, c_im + (size_t)i * 131072, yd);
            k_ssm_out<<<NROWS, 256, 0, st>>>(yd, xn, ssm_d + i * D, merged);
            float* ta = hp; float* tb = hp + (size_t)NROWS * D;
            k_sgemm<<<dim3(D / 64, nrows / 64), 256, 0, st>>>(merged, glu_a + (size_t)i * D * D, ta, D, D, D, D);
            k_sgemm<<<dim3(D / 64, nrows / 64), 256, 0, st>>>(merged, glu_b + (size_t)i * D * D, tb, D, D, D, D);
            k_resid<<<nrows, 256, 0, st>>>(h, ta, tb, modl, 2, 1);
        }
        k_moe<<<nrows, 256, 0, st>>>(h, n2g + layer * D, modl, mgw + (size_t)layer * 4096, mgb + layer * 4, mrw + (size_t)layer * 32768, mrb + layer * 32,
                                    wg + (size_t)layer * 32 * 262144, wu + (size_t)layer * 32 * 262144, wd + (size_t)layer * 32 * 262144);
    }
    k_norm_mod<<<NLAT, 256, 0, st>>>(h, fing, modv, -1, -1, out);
}
extern "C" void kernel_launch(void* const* d_in, const int* in_sizes, int n_in, void* d_out, int out_size, void* d_ws, size_t ws_size, hipStream_t stream) {
    if (n_in != 35 || ws_size < (size_t)460 * 1048576) { fprintf(stderr, "kernel_launch: unexpected n_in %d / ws %zu\n", n_in, ws_size); return; }
    naive_forward(d_in, (float*)d_out, (unsigned char*)d_ws, stream);
}
```

```cpp
#include <hip/hip_runtime.h>
#include <cstdio>
#include <cstdint>
#define MK_ONE_LAUNCH 0
#ifndef MK_F16
#define MK_F16 1
#endif
#if MK_F16
#define PG8_MFMA(a, b, c) __builtin_amdgcn_mfma_f32_16x16x32_f16(__builtin_bit_cast(_Float16 __attribute__((ext_vector_type(8))), a), __builtin_bit_cast(_Float16 __attribute__((ext_vector_type(8))), b), c, 0, 0, 0)
#else
#define PG8_MFMA(a, b, c) __builtin_amdgcn_mfma_f32_16x16x32_bf16(a, b, c, 0, 0, 0)
#endif
namespace pg8 {
#define PG8_LAS __attribute__((address_space(3)))
typedef unsigned short bf16_t;
typedef short bf16x8 __attribute__((ext_vector_type(8)));
typedef float f32x4 __attribute__((ext_vector_type(4)));
typedef unsigned u32x4 __attribute__((ext_vector_type(4)));
constexpr int BM = 256, BK = 64, HALF = 128, HTB = HALF * BK * 2  , STAGE_BYTES = 8 * HTB, NXCD = 8, WGM = 8;

__host__ __device__ __forceinline__ int lds_byte(int r, int c) { const int st = (r >> 4) * 2 + (c >> 5), rr = r & 15, cc = c & 31, ob = rr * 64 + cc * 2; return st * 1024 + (ob ^ (((ob >> 9) & 1) << 5)); }
__host__ __device__ __forceinline__ void stage_rc(int b, int& R, int& C) { const int st = b / 1024, sb = b % 1024, swz = sb ^ (((sb >> 9) & 1) << 5); R = (st >> 1) * 16 + swz / 64; C = (st & 1) * 32 + (swz % 64) / 2; }
__host__ __device__ __forceinline__ int perm32(int rho) { const int n = rho >> 4, i = rho & 15; return 8 * (i >> 2) + 4 * n + (i & 3); }

struct Unit { int pm, pn; };
struct Gemm { const bf16_t* A; const bf16_t* Bt; int M, N, K; };

struct StaticOrder {
    int nM, nN, nwg, G, c;
    __host__ __device__ void init(int M, int N, int G_, int c_) { nM = M / BM; nN = N / BM; nwg = nM * nN; G = G_; c = c_; }
    __host__ __device__ bool next(int i, Unit& u) const {
        const long L = (long)i * G + c; if (L >= nwg) return false;
        int wgid = (int)L; { const int q = nwg / NXCD, r = nwg % NXCD, xcd = wgid % NXCD, off = wgid / NXCD; wgid = (xcd < r ? xcd * (q + 1) : r * (q + 1) + (xcd - r) * q) + off; }
        const int nig = WGM * nN, gid = wgid / nig, fm = gid * WGM, gsz = (nM - fm) < WGM ? (nM - fm) : WGM;
        u.pm = fm + ((wgid % nig) % gsz); u.pn = (wgid % nig) / gsz; return true;
    }
    __device__ __forceinline__ void a_ready(const Unit&) const {}
    __device__ __forceinline__ void done(const Unit&) const {}
};

__device__ __forceinline__ unsigned cvt_pk_bf16(float lo, float hi) { unsigned r; asm volatile("v_cvt_pk_bf16_f32 %0, %1, %2" : "=v"(r) : "v"(lo), "v"(hi)); return r; }
typedef float f32x2 __attribute__((ext_vector_type(2)));
template <class Epi, class Sched, bool ALIGN_EPI = false, bool SP2 = false>
__device__ __forceinline__ void gemm_phase(PG8_LAS unsigned char* lds, const Gemm g, const Sched& S, const Epi& E) {
    int tid_ = threadIdx.x; asm volatile("" : "+v"(tid_));
    const int tid = tid_, wid = __builtin_amdgcn_readfirstlane(tid >> 6), lane = tid & 63, wr = wid >> 2, wc = wid & 3, fr = lane & 15, fq = lane >> 4;
    const int K = g.K, nt = K / BK;
    unsigned voffA[2], voffB[2];
#pragma unroll
    for (int i = 0; i < 2; ++i) { int R, C; stage_rc(tid * 16 + i * 8192, R, C); const int Rb = Epi::PERM ? ((R & ~31) + perm32(R & 31)) : R;
        voffA[i] = (unsigned)(R * K + C) * 2u; voffB[i] = (unsigned)(Rb * K + C) * 2u; }
    const size_t kstep = (size_t)(BK * 2);
    const size_t hstep = (size_t)HALF * K * 2;
    const size_t tstep = 2 * hstep;
    const unsigned ldsw = (unsigned)wid * 1024u;
    const int aoff = lds_byte(wr * 64 + fr, fq * 8), boff = lds_byte(wc * 32 + fr, fq * 8);
#define PG8_SA(b, h) (((b) * 2 + (h)) * HTB)
#define PG8_SB(b, h) ((4 + (b) * 2 + (h)) * HTB)
#define PG8_STAGE(bufoff, gbase, voff) do { _Pragma("unroll") for (int _i = 0; _i < 2; ++_i) \
        __builtin_amdgcn_global_load_lds((const unsigned*)((const char*)(gbase) + (voff)[_i]), (PG8_LAS unsigned*)(lds + (bufoff) + ldsw + _i * 8192), 16, 0, 0); } while (0)
#define PG8_LDA(dst, b, h) do { _Pragma("unroll") for (int m = 0; m < 4; ++m) _Pragma("unroll") for (int k = 0; k < 2; ++k) dst[m][k] = *(const PG8_LAS bf16x8*)(lds + PG8_SA(b, h) + aoff + m * 2048 + k * 1024); } while (0)
#define PG8_LDB(dst, b, h) do { _Pragma("unroll") for (int n = 0; n < 2; ++n) _Pragma("unroll") for (int k = 0; k < 2; ++k) dst[n][k] = *(const PG8_LAS bf16x8*)(lds + PG8_SB(b, h) + boff + n * 2048 + k * 1024); } while (0)
#define PG8_MMA(ai, bj, At, Bt) do { __builtin_amdgcn_s_setprio(1); _Pragma("unroll") for (int m = 0; m < 4; ++m) _Pragma("unroll") for (int n = 0; n < 2; ++n) _Pragma("unroll") for (int k = 0; k < 2; ++k) \
        acc[ai][bj][m][n] = PG8_MFMA(Bt[n][k], At[m][k], acc[ai][bj][m][n]); __builtin_amdgcn_s_setprio(0); } while (0)
#define PG8_WAIT_V(n) asm volatile("s_waitcnt vmcnt(" #n ")" ::: "memory")
#define PG8_WAIT_L(n) asm volatile("s_waitcnt lgkmcnt(" #n ")" ::: "memory")
#define PG8_BAR __builtin_amdgcn_s_barrier()
#define PG8_SCHED __builtin_amdgcn_sched_barrier(0)
    Unit cur, nxt; int ui = 0;
    if (!S.next(0, cur)) return;
    f32x4 acc[2][2][4][2];
#pragma unroll
    for (int a = 0; a < 2; ++a)
#pragma unroll
        for (int b = 0; b < 2; ++b)
#pragma unroll
            for (int m = 0; m < 4; ++m)
#pragma unroll
                for (int n = 0; n < 2; ++n) acc[a][b][m][n] = (f32x4){0.f, 0.f, 0.f, 0.f};
    bf16x8 At[4][2], B0[2][2], B1[2][2];
    const char* cA = (const char*)g.A + (size_t)cur.pm * tstep; const char* cB = (const char*)g.Bt + (size_t)cur.pn * tstep;
    S.a_ready(cur);
    if constexpr (SP2) {
        PG8_STAGE(PG8_SB(0, 0), cB, voffB); PG8_STAGE(PG8_SB(0, 1), cB + hstep, voffB); PG8_STAGE(PG8_SA(0, 0), cA, voffA); PG8_STAGE(PG8_SA(0, 1), cA + hstep, voffA);
        if (wr == 1) PG8_BAR;
        PG8_WAIT_V(2); PG8_BAR;
        PG8_STAGE(PG8_SB(1, 0), cB + kstep, voffB); PG8_STAGE(PG8_SA(1, 0), cA + kstep, voffA); PG8_STAGE(PG8_SB(1, 1), cB + hstep + kstep, voffB);
        PG8_WAIT_V(6); PG8_BAR;
    } else {
        PG8_STAGE(PG8_SB(0, 0), cB, voffB); PG8_STAGE(PG8_SA(0, 0), cA, voffA); PG8_STAGE(PG8_SB(0, 1), cB + hstep, voffB); PG8_STAGE(PG8_SA(0, 1), cA + hstep, voffA);
        if (wr == 1) PG8_BAR;
        PG8_WAIT_V(4); PG8_BAR;
        PG8_STAGE(PG8_SB(1, 0), cB + kstep, voffB); PG8_STAGE(PG8_SA(1, 0), cA + kstep, voffA); PG8_STAGE(PG8_SB(1, 1), cB + hstep + kstep, voffB);
        PG8_WAIT_V(6); PG8_BAR;
    }
    for (;;) {
        const bool has_next = S.next(ui + 1, nxt);
        const char* nA = has_next ? (const char*)g.A + (size_t)nxt.pm * tstep : cA; const char* nB = has_next ? (const char*)g.Bt + (size_t)nxt.pn * tstep : cB;
        for (int t = 0; t < nt; t += 2) {
            const bool last = (t == nt - 2);
            const char* a1 = cA + (size_t)(t + 1) * kstep;
            const char* a2 = last ? nA : cA + (size_t)(t + 2) * kstep; const char* b2 = last ? nB : cB + (size_t)(t + 2) * kstep;
            const char* a3 = a2 + kstep; const char* b3 = b2 + kstep;
            if (last && has_next) S.a_ready(nxt);
            if constexpr (SP2) {
            PG8_LDB(B0, 0, 0); PG8_LDB(B1, 0, 1); PG8_SCHED; PG8_LDA(At, 0, 0); PG8_STAGE(PG8_SA(1, 1), a1 + hstep, voffA);
            PG8_WAIT_V(8); PG8_WAIT_L(0); PG8_BAR; PG8_MMA(0, 0, At, B0); PG8_MMA(0, 1, At, B1); PG8_BAR; PG8_SCHED;
            PG8_LDA(At, 0, 1); PG8_STAGE(PG8_SB(0, 0), b2, voffB); PG8_STAGE(PG8_SB(0, 1), b2 + hstep, voffB); PG8_STAGE(PG8_SA(0, 0), a2, voffA);
            PG8_WAIT_V(8); PG8_WAIT_L(0); PG8_BAR; PG8_MMA(1, 0, At, B0); PG8_MMA(1, 1, At, B1); PG8_BAR; PG8_SCHED;
            PG8_LDB(B0, 1, 0); PG8_LDB(B1, 1, 1); PG8_SCHED; PG8_LDA(At, 1, 0); PG8_STAGE(PG8_SA(0, 1), a2 + hstep, voffA);
            PG8_WAIT_V(8); PG8_WAIT_L(0); PG8_BAR; PG8_MMA(0, 0, At, B0); PG8_MMA(0, 1, At, B1); PG8_BAR; PG8_SCHED;
            PG8_LDA(At, 1, 1); PG8_STAGE(PG8_SB(1, 0), b3, voffB); PG8_STAGE(PG8_SB(1, 1), b3 + hstep, voffB); PG8_STAGE(PG8_SA(1, 0), a3, voffA);
            PG8_WAIT_V(8); PG8_WAIT_L(0); PG8_BAR; PG8_MMA(1, 0, At, B0); PG8_MMA(1, 1, At, B1); PG8_BAR; PG8_SCHED;
            } else {
            PG8_LDB(B0, 0, 0); PG8_SCHED; PG8_LDA(At, 0, 0); PG8_STAGE(PG8_SA(1, 1), a1 + hstep, voffA);
            PG8_WAIT_L(8); PG8_BAR; PG8_WAIT_L(0); PG8_MMA(0, 0, At, B0); PG8_BAR; PG8_SCHED;
            PG8_LDB(B1, 0, 1); PG8_STAGE(PG8_SB(0, 0), b2, voffB);
            PG8_BAR; PG8_WAIT_L(0); PG8_MMA(0, 1, At, B1); PG8_BAR;
            PG8_LDA(At, 0, 1); PG8_STAGE(PG8_SA(0, 0), a2, voffA);
            PG8_BAR; PG8_WAIT_L(0); PG8_MMA(1, 0, At, B0); PG8_BAR; PG8_SCHED;
            PG8_STAGE(PG8_SB(0, 1), b2 + hstep, voffB);
            PG8_WAIT_V(6); PG8_BAR; PG8_MMA(1, 1, At, B1); PG8_BAR;
            PG8_LDB(B0, 1, 0); PG8_SCHED; PG8_LDA(At, 1, 0); PG8_STAGE(PG8_SA(0, 1), a2 + hstep, voffA);
            PG8_WAIT_L(8); PG8_BAR; PG8_WAIT_L(0); PG8_MMA(0, 0, At, B0); PG8_BAR; PG8_SCHED;
            PG8_LDB(B1, 1, 1); PG8_STAGE(PG8_SB(1, 0), b3, voffB);
            PG8_BAR; PG8_WAIT_L(0); PG8_MMA(0, 1, At, B1); PG8_BAR;
            PG8_LDA(At, 1, 1); PG8_STAGE(PG8_SA(1, 0), a3, voffA);
            PG8_BAR; PG8_WAIT_L(0); PG8_MMA(1, 0, At, B0); PG8_BAR; PG8_SCHED;
            PG8_STAGE(PG8_SB(1, 1), b3 + hstep, voffB);
            PG8_WAIT_V(6); PG8_BAR; PG8_MMA(1, 1, At, B1); PG8_BAR;
            }
        }
        if constexpr (ALIGN_EPI) { if (wr == 0) PG8_BAR; }
        if constexpr (!Epi::AFTER_DRAIN) { E(acc, cur, wr, wc, fr, fq); S.done(cur); }
        if (!has_next) break;
#pragma unroll
        for (int a = 0; a < 2; ++a)
#pragma unroll
            for (int b = 0; b < 2; ++b)
#pragma unroll
                for (int m = 0; m < 4; ++m)
#pragma unroll
                    for (int n = 0; n < 2; ++n) acc[a][b][m][n] = (f32x4){0.f, 0.f, 0.f, 0.f};
        cur = nxt; cA = nA; cB = nB; ++ui;
        if constexpr (ALIGN_EPI) { if (wr == 1) PG8_BAR; }
    }
    PG8_WAIT_V(0);
    if constexpr (!ALIGN_EPI) { if (wr == 0) PG8_BAR; }
    PG8_BAR;
    if constexpr (Epi::AFTER_DRAIN) { E.fused(acc, cur, wr, wc, fr, fq, lds, wid, lane); S.done(cur); }
#undef PG8_SA
#undef PG8_SB
#undef PG8_STAGE
#undef PG8_LDA
#undef PG8_LDB
#undef PG8_MMA
#undef PG8_WAIT_V
#undef PG8_WAIT_L
#undef PG8_BAR
#undef PG8_SCHED
}
}
#define GAS __attribute__((address_space(1)))
#define LAS __attribute__((address_space(3)))
typedef unsigned short bf16;
typedef unsigned u32x4 __attribute__((ext_vector_type(4)));
typedef unsigned u32x2 __attribute__((ext_vector_type(2)));
typedef float f32x4 __attribute__((ext_vector_type(4)));
typedef float f32x2 __attribute__((ext_vector_type(2)));
typedef float f32x16 __attribute__((ext_vector_type(16)));
typedef short bf16x8 __attribute__((ext_vector_type(8)));
typedef short s16x4 __attribute__((ext_vector_type(4)));
typedef short v4i16_t __attribute__((ext_vector_type(4)));

constexpr int D = 1024, NLAT = 16384, NCTXR = 2048, NROWS = 18432;
constexpr size_t MiB = 1u << 20;
constexpr size_t WS_CTL = 0, CTL_ZERO_BYTES = 128 * 1024;
constexpr size_t WS_MODV = 1 * MiB;
constexpr size_t WS_TAB = 2 * MiB;
constexpr size_t WS_WQKV = 3 * MiB, WS_WO = 12 * MiB, WS_WGLU = 16 * MiB, WS_WGU = 24 * MiB, WS_WD = 152 * MiB, WS_SSM = 216 * MiB;
constexpr size_t WS_H = 264 * MiB, WS_XN = 336 * MiB, WS_ARENA = 372 * MiB, WS_END = 570 * MiB;
constexpr size_t WS_Q = WS_ARENA, WS_K = WS_Q + (size_t)NROWS * 1024 * 2, WS_V = WS_K + (size_t)NROWS * 640 * 2, WS_O12 = WS_ARENA + 81 * MiB, WS_MERGED = WS_ARENA + 153 * MiB;
constexpr int MAXSLOT = 45056;
constexpr size_t WS_XS = WS_ARENA, WS_HID = WS_ARENA + 88 * MiB, WS_YS = WS_ARENA + 110 * MiB;
static_assert(WS_V + (size_t)NROWS * 640 * 2 <= WS_O12 && WS_O12 + (size_t)NROWS * 1024 * 4 <= WS_MERGED && WS_MERGED + (size_t)NROWS * 1024 * 2 <= WS_END, "mixer arena");
static_assert((size_t)MAXSLOT * 2048 <= 88 * MiB && (size_t)MAXSLOT * 512 <= 22 * MiB && WS_YS + (size_t)MAXSLOT * 2048 <= WS_END, "moe arena");
constexpr size_t TAB_ROUTE_I = 64 * 1024, TAB_ROUTE_W = 384 * 1024, TAB_ROUTE_S = 576 * 1024, TAB_WSLOT = 768 * 1024;
constexpr int CW_BAR = 1024;
constexpr int CW_CNT = 8192;
constexpr int CW_TILE = 8192 + 4 * 32 * 64;
static_assert((CW_TILE + 4 * 256) * 4 <= (int)CTL_ZERO_BYTES, "ctl");
constexpr int PH_LDS = 155648, LDS_BARW = PH_LDS, LDS_BYTES = PH_LDS + 256;

#ifndef MK_F16
#define MK_F16 1
#endif
typedef _Float16 h16x8 __attribute__((ext_vector_type(8)));
typedef _Float16 h16x2 __attribute__((ext_vector_type(2)));
#if MK_F16
__device__ __forceinline__ float clamp16(float f) { return fminf(fmaxf(f, -65504.f), 65504.f); }
__device__ __forceinline__ unsigned f2bf(float f) { return (unsigned)__builtin_bit_cast(unsigned short, (_Float16)f); }
__device__ __forceinline__ unsigned pk2(float lo, float hi) { const h16x2 v = {(_Float16)lo, (_Float16)hi}; return __builtin_bit_cast(unsigned, v); }
__device__ __forceinline__ float bf2f(unsigned short h) { return (float)__builtin_bit_cast(_Float16, h); }
__device__ __forceinline__ float bflo(unsigned w) { return (float)__builtin_bit_cast(h16x2, w)[0]; }
__device__ __forceinline__ float bfhi(unsigned w) { return (float)__builtin_bit_cast(h16x2, w)[1]; }
#define MFMA16(a, b, c) __builtin_amdgcn_mfma_f32_16x16x32_f16(__builtin_bit_cast(h16x8, a), __builtin_bit_cast(h16x8, b), c, 0, 0, 0)
#define MFMA32(a, b, c) __builtin_amdgcn_mfma_f32_32x32x16_f16(__builtin_bit_cast(h16x8, a), __builtin_bit_cast(h16x8, b), c, 0, 0, 0)
#else
__device__ __forceinline__ float clamp16(float f) { return f; }
__device__ __forceinline__ unsigned f2bf(float f) { unsigned u = __builtin_bit_cast(unsigned, f); return (u + 0x7fffu + ((u >> 16) & 1u)) >> 16; }
__device__ __forceinline__ unsigned pk2(float lo, float hi) { return f2bf(lo) | (f2bf(hi) << 16); }
__device__ __forceinline__ float bf2f(unsigned short h) { return __builtin_bit_cast(float, (unsigned)h << 16); }
__device__ __forceinline__ float bflo(unsigned w) { return __builtin_bit_cast(float, w << 16); }
__device__ __forceinline__ float bfhi(unsigned w) { return __builtin_bit_cast(float, w & 0xffff0000u); }
#define MFMA16(a, b, c) __builtin_amdgcn_mfma_f32_16x16x32_bf16(a, b, c, 0, 0, 0)
#define MFMA32(a, b, c) __builtin_amdgcn_mfma_f32_32x32x16_bf16(a, b, c, 0, 0, 0)
#endif
template <int M> __device__ __forceinline__ float swz_xor(float v) { return __builtin_bit_cast(float, __builtin_amdgcn_ds_swizzle(__builtin_bit_cast(int, v), (M << 10) | 0x1f)); }
__device__ __forceinline__ void xor32_pair(float v, float& r0, float& r1) { float a = v, b = v;
    asm volatile("s_nop 1\n\tv_permlane32_swap_b32 %0, %1" : "+v"(a), "+v"(b));
    r0 = a; r1 = b; }
__device__ __forceinline__ float xor32_sum(float v) { float a, b; xor32_pair(v, a, b); return a + b; }
__device__ __forceinline__ float xor32_max(float v) { float a, b; xor32_pair(v, a, b); return fmaxf(a, b); }
__device__ __forceinline__ float wave_sum(float v) {
    v += swz_xor<1>(v); v += swz_xor<2>(v); v += swz_xor<4>(v); v += swz_xor<8>(v); v += swz_xor<16>(v);
    const int vi = __builtin_bit_cast(int, v);
    return __builtin_bit_cast(float, __builtin_amdgcn_readlane(vi, 0)) + __builtin_bit_cast(float, __builtin_amdgcn_readlane(vi, 32));
}
__device__ __forceinline__ unsigned ld_agent(const unsigned* p) { return __hip_atomic_load(p, __ATOMIC_RELAXED, __HIP_MEMORY_SCOPE_AGENT); }
__device__ __forceinline__ int mrow_of(int row) { return row < NLAT ? (row >> 11) : 8; }
__device__ __forceinline__ float gelu_tanh_f(float x) {
    const float u = 0.7978845608028654f * (x + 0.044715f * x * x * x);
    return x / (1.f + __expf(-2.f * u));
}
__device__ __forceinline__ float sigmoid_f(float x) { return 1.f / (1.f + __expf(-x)); }

#define XB_TMO      128
#define XB_XCNT(j)  (256  + 64 * (j))
#define XB_XSUB(j)  (1280 + 64 * (j))
#define XB_XGEN(j)  (2304 + 64 * (j))
#define XB_TOP      3328
#define XB_TOPGEN   3392
#define XCD_BAR_WORDS 3456
#define XB_SPIN_CAP (1u << 18)
__device__ __forceinline__ unsigned xb_ld(unsigned* p)              { return __hip_atomic_load(p, __ATOMIC_RELAXED, __HIP_MEMORY_SCOPE_AGENT); }
__device__ __forceinline__ unsigned xb_add(unsigned* p, unsigned v) { return __hip_atomic_fetch_add(p, v, __ATOMIC_RELAXED, __HIP_MEMORY_SCOPE_AGENT); }
__device__ __forceinline__ unsigned xb_xcc_id() { return (unsigned)__builtin_amdgcn_s_getreg((3 << 11) | 20) & 0xFu; }
#define XB_SPIN(cond, bar) do { unsigned _sp = 0; while (cond) { __builtin_amdgcn_s_sleep(1); \
    if ((++_sp & 255u) == 0u) { if (xb_ld(&(bar)[XB_TMO])) break; if (_sp > XB_SPIN_CAP) { atomicAdd(&(bar)[XB_TMO], 1u); break; } } } } while (0)
struct XcdBarrier { unsigned* bar; unsigned x; volatile LAS unsigned* st; };
__device__ __forceinline__ XcdBarrier xcd_barrier_post(unsigned* bar, volatile LAS unsigned* st) {
    XcdBarrier b; b.bar = bar; b.x = xb_xcc_id(); b.st = st;
    if (threadIdx.x == 0) (void)xb_add(&bar[XB_XCNT(b.x)], 1u);
    return b;
}
__device__ __forceinline__ void xcd_barrier_complete(unsigned* bar, unsigned x, unsigned& nloc, unsigned& nx) {
    const unsigned G = gridDim.x * gridDim.y * gridDim.z;
    unsigned sum, cnt, mine, sp = 0u;
    for (;;) {
        sum = 0u; cnt = 0u; mine = 0u;
#pragma unroll
        for (unsigned j = 0; j < 16; ++j) { const unsigned c = xb_ld(&bar[XB_XCNT(j)]); sum += c; cnt += (c > 0u) ? 1u : 0u; mine = (j == x) ? c : mine; }
        if (sum == G) break;
        __builtin_amdgcn_s_sleep(1);
        if ((++sp & 255u) == 0u) { if (xb_ld(&bar[XB_TMO])) break; if (sp > XB_SPIN_CAP) { atomicAdd(&bar[XB_TMO], 1u); break; } }
    }
    nloc = mine > 0u ? mine : 1u; nx = cnt > 0u ? cnt : 1u;
}
template <bool FIRST> __device__ __forceinline__ void xcd_barrier(const XcdBarrier& b) {
    asm volatile("s_waitcnt vmcnt(0)" ::: "memory");
    __syncthreads();
    if (threadIdx.x == 0) {
        unsigned* bar = b.bar;
        __builtin_amdgcn_s_waitcnt(0);
        unsigned nloc = b.st[0], nx = b.st[1];
        if (FIRST) { if (nloc == 0u) { xcd_barrier_complete(bar, b.x, nloc, nx); b.st[0] = nloc; b.st[1] = nx; } }
        const unsigned old = xb_add(&bar[XB_XSUB(b.x)], 1u);
        const unsigned gen = old / nloc;
        if (old + 1u == (gen + 1u) * nloc) {
            __builtin_amdgcn_fence(__ATOMIC_RELEASE, "agent");
            asm volatile("s_waitcnt vmcnt(0)" ::: "memory");
            const unsigned og = xb_add(&bar[XB_TOP], 1u);
            const unsigned tg = og / nx;
            if (og + 1u == (tg + 1u) * nx) xb_add(&bar[XB_TOPGEN], 1u);
            else XB_SPIN(xb_ld(&bar[XB_TOPGEN]) == tg, bar);
            __builtin_amdgcn_fence(__ATOMIC_ACQUIRE, "agent");
            xb_add(&bar[XB_XGEN(b.x)], 1u);
            asm volatile("s_waitcnt vmcnt(0)" ::: "memory");
        } else {
            XB_SPIN(xb_ld(&bar[XB_XGEN(b.x)]) == gen, bar);
            __builtin_amdgcn_fence(__ATOMIC_ACQUIRE, "agent");
            asm volatile("s_waitcnt vmcnt(0)" ::: "memory");
        }
    }
    __syncthreads();
}

using pg8::Unit; using pg8::HALF; using pg8::BM;

struct EpiQKV {
    static constexpr bool PERM = true, AFTER_DRAIN = false;
    bf16* Q; bf16* K; bf16* V; const float* qg; const float* kg; const float* rope;
    __device__ __forceinline__ void operator()(const f32x4 (&acc)[2][2][4][2], const Unit& u, int wr, int wc, int fr, int fq) const {
        const int hs = u.pn * 4 + wc;
        const bool is_q = hs < 8 || (hs >= 12 && hs < 20), is_k = (hs >= 8 && hs < 10) || (hs >= 20 && hs < 28);
        const bool do_norm = hs < 10, do_rope = (is_q || is_k) && (u.pm < 64);
        bf16* dst; int pitch;
        if (is_q) { dst = Q + (hs < 8 ? hs : hs - 4) * 64; pitch = 1024; }
        else if (is_k) { dst = K + (hs < 10 ? hs - 8 : hs - 18) * 64; pitch = 640; }
        else { dst = V + (hs < 12 ? hs - 10 : hs - 26) * 64; pitch = 640; }
        const float qscale = is_q ? 0.125f * 1.4426950408889634f : 1.0f;
        f32x4 gv[2][2];
#pragma unroll
        for (int bj = 0; bj < 2; ++bj)
#pragma unroll
            for (int n = 0; n < 2; ++n) gv[bj][n] = do_norm ? *(const f32x4*)((hs < 8 ? qg : kg) + 32 * bj + 16 * n + 4 * fq) : (f32x4){1.f, 1.f, 1.f, 1.f};
#pragma unroll
        for (int ai = 0; ai < 2; ++ai)
#pragma unroll
            for (int m = 0; m < 4; ++m) {
                const int row = u.pm * BM + ai * HALF + wr * 64 + m * 16 + fr;
                f32x4 v[2][2];
#pragma unroll
                for (int bj = 0; bj < 2; ++bj)
#pragma unroll
                    for (int n = 0; n < 2; ++n) v[bj][n] = acc[ai][bj][m][n];
                if (do_norm) {
                    float ss = 0.f;
#pragma unroll
                    for (int bj = 0; bj < 2; ++bj)
#pragma unroll
                        for (int n = 0; n < 2; ++n) ss += (v[bj][n][0] * v[bj][n][0] + v[bj][n][1] * v[bj][n][1]) + (v[bj][n][2] * v[bj][n][2] + v[bj][n][3] * v[bj][n][3]);
                    ss += swz_xor<16>(ss); ss = xor32_sum(ss);
                    const float r = rsqrtf(ss * (1.f / 64.f) + 1e-6f);
#pragma unroll
                    for (int bj = 0; bj < 2; ++bj)
#pragma unroll
                        for (int n = 0; n < 2; ++n) v[bj][n] = v[bj][n] * r * gv[bj][n];
                }
                if (do_rope) {
                    const int t = row & 2047;
#pragma unroll
                    for (int bj = 0; bj < 2; ++bj) {
                        const int pos = bj == 0 ? (t >> 6) : (t & 63);
                        const float* tp = rope + (pos * 16 + 4 * fq) * 2;
                        const f32x4 t0 = *(const f32x4*)tp, t1 = *(const f32x4*)(tp + 4);
                        const f32x4 cs = {t0[0], t0[2], t1[0], t1[2]}, sn = {t0[1], t0[3], t1[1], t1[3]};
                        const f32x4 x0 = v[bj][0], x1 = v[bj][1];
                        v[bj][0] = x0 * cs - x1 * sn; v[bj][1] = x1 * cs + x0 * sn;
                    }
                }
                bf16* rp = dst + (size_t)row * pitch;
#pragma unroll
                for (int bj = 0; bj < 2; ++bj)
#pragma unroll
                    for (int n = 0; n < 2; ++n) { const f32x4 o = v[bj][n] * qscale; u32x2 w; w.x = pk2(o[0], o[1]); w.y = pk2(o[2], o[3]);
                        *(u32x2*)(rp + 32 * bj + 16 * n + 4 * fq) = w; }
            }
    }
};
struct EpiResid {
    static constexpr bool PERM = false, AFTER_DRAIN = false;
    float* h; const float* gate;
    __device__ __forceinline__ void operator()(const f32x4 (&acc)[2][2][4][2], const Unit& u, int wr, int wc, int fr, int fq) const {
        const int mr = u.pm < 64 ? (u.pm >> 3) : 8; const float* gp = gate + mr * 6144;
        const int row0 = u.pm * BM + wr * 64 + fr, col0 = u.pn * BM + wc * 32 + 4 * fq;
#pragma unroll
        for (int bj = 0; bj < 2; ++bj)
#pragma unroll
            for (int n = 0; n < 2; ++n) { const int col = col0 + bj * HALF + 16 * n; const f32x4 gv = *(const f32x4*)(gp + col);
#pragma unroll
                for (int ai = 0; ai < 2; ++ai)
#pragma unroll
                    for (int m = 0; m < 4; ++m) { float* p = h + (size_t)(row0 + ai * HALF + m * 16) * D + col; *(f32x4*)p = *(const f32x4*)p + gv * acc[ai][bj][m][n]; } }
    }
};
struct EpiGLU {
    static constexpr bool PERM = true, AFTER_DRAIN = false;
    float* h; const float* gate;
    __device__ __forceinline__ void operator()(const f32x4 (&acc)[2][2][4][2], const Unit& u, int wr, int wc, int fr, int fq) const {
        const int mr = u.pm < 64 ? (u.pm >> 3) : 8; const float* gp = gate + mr * 6144;
        const int row0 = u.pm * BM + wr * 64 + fr, col0 = u.pn * 128 + wc * 16 + 4 * fq;
#pragma unroll
        for (int bj = 0; bj < 2; ++bj) { const int col = col0 + bj * 64; const f32x4 gv = *(const f32x4*)(gp + col);
#pragma unroll
            for (int ai = 0; ai < 2; ++ai)
#pragma unroll
                for (int m = 0; m < 4; ++m) { float* p = h + (size_t)(row0 + ai * HALF + m * 16) * D + col; const f32x4 a = acc[ai][bj][m][0], b = acc[ai][bj][m][1];
                    f32x4 y; y[0] = a[0] * sigmoid_f(b[0]); y[1] = a[1] * sigmoid_f(b[1]); y[2] = a[2] * sigmoid_f(b[2]); y[3] = a[3] * sigmoid_f(b[3]);
                    *(f32x4*)p = *(const f32x4*)p + gv * y; } }
    }
};
struct EpiGateUp {
    static constexpr bool PERM = true, AFTER_DRAIN = false;
    bf16* hid; const float* wslot;
    __device__ __forceinline__ void operator()(const f32x4 (&acc)[2][2][4][2], const Unit& u, int wr, int wc, int fr, int fq) const {
        const int row0 = u.pm * BM + wr * 64 + fr, col0 = (u.pn & 1) * 128 + wc * 16 + 4 * fq;
#pragma unroll
        for (int ai = 0; ai < 2; ++ai)
#pragma unroll
            for (int m = 0; m < 4; ++m) { const int row = row0 + ai * HALF + m * 16; const float w = wslot[row];
#pragma unroll
                for (int bj = 0; bj < 2; ++bj) { const f32x4 g = acc[ai][bj][m][0], up = acc[ai][bj][m][1]; f32x4 y;
                    y[0] = g[0] * sigmoid_f(g[0]) * up[0] * w; y[1] = g[1] * sigmoid_f(g[1]) * up[1] * w; y[2] = g[2] * sigmoid_f(g[2]) * up[2] * w; y[3] = g[3] * sigmoid_f(g[3]) * up[3] * w;
                    u32x2 o; o.x = pk2(clamp16(y[0]), clamp16(y[1])); o.y = pk2(clamp16(y[2]), clamp16(y[3]));
                    *(u32x2*)(hid + (size_t)row * 256 + col0 + bj * 64) = o; } }
    }
};
struct EpiDown {
    static constexpr bool PERM = true, AFTER_DRAIN = false;
    bf16* ys;
    __device__ __forceinline__ void operator()(const f32x4 (&acc)[2][2][4][2], const Unit& u, int wr, int wc, int fr, int fq) const {
        const int row0 = u.pm * BM + wr * 64 + fr, col0 = (u.pn & 3) * 256 + wc * 32 + 8 * fq;
#pragma unroll
        for (int ai = 0; ai < 2; ++ai)
#pragma unroll
            for (int m = 0; m < 4; ++m) { bf16* rp = ys + (size_t)(row0 + ai * HALF + m * 16) * D + col0;
#pragma unroll
                for (int bj = 0; bj < 2; ++bj) { const f32x4 v0 = acc[ai][bj][m][0], v1 = acc[ai][bj][m][1]; u32x4 w; w.x = pk2(clamp16(v0[0]), clamp16(v0[1])); w.y = pk2(clamp16(v0[2]), clamp16(v0[3])); w.z = pk2(clamp16(v1[0]), clamp16(v1[1])); w.w = pk2(clamp16(v1[2]), clamp16(v1[3]));
                    *(u32x4*)(rp + bj * HALF) = w; } }
    }
};
struct MoeOrder {
    const unsigned* tbl; int nsub, G, c;
    __device__ __forceinline__ bool next(int i, Unit& u) const {
        const int L = i * G + c; const int T = (int)__builtin_amdgcn_readfirstlane(ld_agent(tbl));
        if (L >= T * nsub) return false;
        const int t = L / nsub, s = L - t * nsub; const int e = (int)__builtin_amdgcn_readfirstlane(ld_agent(tbl + 1 + t));
        u.pm = t; u.pn = e * nsub + s; return true;
    }
    __device__ __forceinline__ void a_ready(const Unit&) const {}
    __device__ __forceinline__ void done(const Unit&) const {}
};
constexpr int AT_KOFF0 = 0, AT_VOFF0 = 8192, AT_BUF = 24576, AT_SCR = 49152;
__device__ __forceinline__ int crow(int r, int hi) { return (r & 3) + 8 * (r >> 2) + 4 * hi; }
__device__ __forceinline__ int v_off(int kv, int col) { return (col >> 5) * 4096 + (kv >> 3) * 512 + (kv & 7) * 64 + (col & 31) * 2; }
__device__ __forceinline__ s16x4 vtr(const LAS unsigned char* p) { return __builtin_bit_cast(s16x4, __builtin_amdgcn_ds_read_tr16_b64_v4i16((LAS v4i16_t*)p)); }

template <int VD>
__device__ __forceinline__ void attn_unit(LAS unsigned char* lds, const bf16* Qb, const bf16* Kb, const bf16* Vb, bf16* merged, float* o12,
                                          int b, int qrow0, bool lat, int qcol, int kcol, int vcol, int ocol) {
    int tid_ = threadIdx.x; asm volatile("" : "+v"(tid_));
    const int tid = tid_, lane = tid & 63, r32 = lane & 31, hi = lane >> 5; const int wid = __builtin_amdgcn_readfirstlane(tid >> 6);
    constexpr int NDB = VD / 32, NVP = VD / 64;
    const int NT = lat ? 36 : 4;
    const int k_kv = tid >> 3, k_c = tid & 7;
    const int k_dst = k_kv * 128 + ((k_c ^ ((k_kv >> 1) & 7)) << 4);
    int v_kv[NVP], v_c8[NVP], v_dst[NVP];
#pragma unroll
    for (int i = 0; i < NVP; ++i) { const int id = tid + 512 * i; v_kv[i] = VD == 64 ? (id >> 3) : (id >> 4); v_c8[i] = VD == 64 ? (id & 7) : (id & 15); v_dst[i] = v_off(v_kv[i], v_c8[i] * 8); }
    auto tile_row0 = [&](int t) -> int { return lat ? (t < 4 ? NLAT + b * 256 + t * 64 : b * 2048 + (t - 4) * 64) : NLAT + b * 256 + t * 64; };
    bf16x8 qf[4];
    { const bf16* qp = Qb + (size_t)(qrow0 + wid * 32 + r32) * 1024 + qcol + hi * 8;
#pragma unroll
      for (int d0 = 0; d0 < 4; ++d0) qf[d0] = *(const bf16x8*)(qp + d0 * 16); }
    f32x16 o[NDB];
#pragma unroll
    for (int i = 0; i < NDB; ++i) o[i] = (f32x16){};
    float m_run = -1e30f, l_run = 0.f;
    LAS float* scr = (LAS float*)(lds + AT_SCR) + wid * 32;
    u32x4 kreg, vreg[NVP];
    { const int r0 = tile_row0(0);
      kreg = *(const u32x4*)(Kb + (size_t)(r0 + k_kv) * 640 + kcol + k_c * 8);
#pragma unroll
      for (int i = 0; i < NVP; ++i) vreg[i] = *(const u32x4*)(Vb + (size_t)(r0 + v_kv[i]) * 640 + vcol + v_c8[i] * 8);
      *(LAS u32x4*)(lds + AT_KOFF0 + k_dst) = kreg;
#pragma unroll
      for (int i = 0; i < NVP; ++i) *(LAS u32x4*)(lds + AT_VOFF0 + v_dst[i]) = vreg[i]; }
    __syncthreads();
    const int ka_off = r32 * 128, ksw = (r32 >> 1) & 7;
    const int vt_off = ((lane >> 4) & 1) * 32 + (lane & 3) * 8 + (4 * hi + ((lane & 15) >> 2)) * 64;
    for (int t = 0; t < NT; ++t) {
        const int cur = (t & 1) * AT_BUF;
        if (t + 1 < NT) { const int r0 = tile_row0(t + 1);
            kreg = *(const u32x4*)(Kb + (size_t)(r0 + k_kv) * 640 + kcol + k_c * 8);
#pragma unroll
            for (int i = 0; i < NVP; ++i) vreg[i] = *(const u32x4*)(Vb + (size_t)(r0 + v_kv[i]) * 640 + vcol + v_c8[i] * 8); }
        f32x16 p0 = (f32x16){}, p1 = (f32x16){};
        const LAS unsigned char* kb = lds + cur + AT_KOFF0 + ka_off;
#pragma unroll
        for (int d0 = 0; d0 < 4; ++d0) { const int ch = ((2 * d0 + hi) ^ ksw) << 4;
            const bf16x8 a0 = *(const LAS bf16x8*)(kb + ch), a1 = *(const LAS bf16x8*)(kb + 4096 + ch);
            p0 = MFMA32(a0, qf[d0], p0);
            p1 = MFMA32(a1, qf[d0], p1); }
        float mx = fmaxf(p0[0], p1[0]);
#pragma unroll
        for (int r = 1; r < 16; ++r) mx = fmaxf(mx, fmaxf(p0[r], p1[r]));
        mx = xor32_max(mx);
        const float m_new = fmaxf(m_run, mx);
        if (__any(m_new > m_run)) {
            const float alpha = __builtin_amdgcn_exp2f(m_run - m_new);
            l_run *= alpha; m_run = m_new;
            if (hi == 0) scr[r32] = alpha;
            f32x4 a4[4];
#pragma unroll
            for (int i = 0; i < 4; ++i) a4[i] = *(const LAS f32x4*)(scr + 8 * i + 4 * hi);
#pragma unroll
            for (int db = 0; db < NDB; ++db)
#pragma unroll
                for (int r = 0; r < 16; ++r) o[db][r] *= a4[r >> 2][r & 3];
        }
        float ls = 0.f;
#pragma unroll
        for (int r = 0; r < 16; ++r) { p0[r] = __builtin_amdgcn_exp2f(p0[r] - m_run); p1[r] = __builtin_amdgcn_exp2f(p1[r] - m_run); ls += p0[r] + p1[r]; }
        l_run += ls;
        u32x4 pw[4];
#pragma unroll
        for (int i = 0; i < 4; ++i) { pw[0][i] = pk2(p0[2 * i], p0[2 * i + 1]); pw[1][i] = pk2(p0[8 + 2 * i], p0[9 + 2 * i]); pw[2][i] = pk2(p1[2 * i], p1[2 * i + 1]); pw[3][i] = pk2(p1[8 + 2 * i], p1[9 + 2 * i]); }
        const LAS unsigned char* vb = lds + cur + AT_VOFF0 + vt_off;
#pragma unroll
        for (int db = 0; db < NDB; ++db)
#pragma unroll
            for (int ks = 0; ks < 4; ++ks) { const s16x4 lo = vtr(vb + db * 4096 + ks * 1024), hh = vtr(vb + db * 4096 + ks * 1024 + 512);
                const bf16x8 vf = {lo[0], lo[1], lo[2], lo[3], hh[0], hh[1], hh[2], hh[3]};
                o[db] = MFMA32(__builtin_bit_cast(bf16x8, pw[ks]), vf, o[db]); }
        if (t + 1 < NT) { const int nxt = ((t + 1) & 1) * AT_BUF;
            *(LAS u32x4*)(lds + nxt + AT_KOFF0 + k_dst) = kreg;
#pragma unroll
            for (int i = 0; i < NVP; ++i) *(LAS u32x4*)(lds + nxt + AT_VOFF0 + v_dst[i]) = vreg[i]; }
        __syncthreads();
    }
    l_run = xor32_sum(l_run);
    if (hi == 0) scr[r32] = 1.f / l_run;
    f32x4 a4[4];
#pragma unroll
    for (int i = 0; i < 4; ++i) a4[i] = *(const LAS f32x4*)(scr + 8 * i + 4 * hi);
#pragma unroll
    for (int r = 0; r < 16; ++r) { const int row = qrow0 + wid * 32 + crow(r, hi); const float li = a4[r >> 2][r & 3];
#pragma unroll
        for (int db = 0; db < NDB; ++db) {
            if (VD == 64) merged[(size_t)row * D + ocol + db * 32 + r32] = (bf16)f2bf(o[db][r] * li);
            else o12[(size_t)row * D + ocol + db * 32 + r32] = o[db][r] * li; } }
    __syncthreads();
}

constexpr int SS_AST = 1040;
__device__ __forceinline__ int ssm_row(int b, int j, int t) { return j < 16 ? NLAT + b * 256 + 16 * j + t : b * 2048 + 16 * (j - 16) + t; }
__device__ __forceinline__ void ssm_unit(LAS unsigned char* lds, int b, int g, const bf16* xn, bf16* gout, const bf16* W1t, const bf16* W2t,
                                         const float* are, const float* aim, const float* logdt, const float* dskip) {
    int tid_ = threadIdx.x; asm volatile("" : "+v"(tid_));
    const int tid = tid_, lane = tid & 63, fr = lane & 15, fq = lane >> 4; const int w = __builtin_amdgcn_readfirstlane(tid >> 6);
    for (int id = tid; id < 144 * 32; id += 512) { const int j = id >> 5, rem = id & 31, t = rem >> 1, hf = rem & 1;
        const u32x4 v = *(const u32x4*)(xn + (size_t)ssm_row(b, j, t) * D + 16 * g + 8 * hf);
        *(LAS u32x4*)(lds + j * SS_AST + (t * 16 + 8 * hf) * 2) = v; }
    __syncthreads();
    f32x4 acc[9][2];
    bf16x8 bfr[2][8];
#pragma unroll
    for (int rt = 0; rt < 9; ++rt) { acc[rt][0] = (f32x4){0.f, 0.f, 0.f, 0.f}; acc[rt][1] = (f32x4){0.f, 0.f, 0.f, 0.f}; }
#pragma unroll
    for (int ct = 0; ct < 2; ++ct)
#pragma unroll
        for (int ks = 0; ks < 8; ++ks) bfr[ct][ks] = *(const bf16x8*)(W1t + (size_t)(32 * w + 16 * ct + fr) * 256 + 32 * ks + 8 * fq);
#pragma unroll
    for (int rt = 0; rt < 9; ++rt)
#pragma unroll
        for (int ks = 0; ks < 8; ++ks) { const bf16x8 a = *(const LAS bf16x8*)(lds + (16 * rt + fr) * SS_AST + (32 * ks + 8 * fq) * 2);
            acc[rt][0] = MFMA16(a, bfr[0][ks], acc[rt][0]);
            acc[rt][1] = MFMA16(a, bfr[1][ks], acc[rt][1]); }
#pragma unroll
    for (int rt = 0; rt < 9; ++rt)
#pragma unroll
        for (int ct = 0; ct < 2; ++ct)
#pragma unroll
            for (int r = 0; r < 4; ++r) *(LAS bf16*)(lds + (16 * rt + 4 * fq + r) * SS_AST + (256 + 32 * w + 16 * ct + fr) * 2) = (bf16)f2bf(clamp16(acc[rt][ct][r]));
    __syncthreads();
    if (tid < 128) {
        const int dir = tid >> 6, p = tid & 63; const int gp = (dir * 64 + g) * 64 + p;
        const float lre = fminf(are[gp], -1e-4f), lim = aim[gp], dt = expf(logdt[dir * 64 + g]);
        const float mag = expf(16.f * lre * dt), ang = 16.f * lim * dt; const float l16r = mag * cosf(ang), l16i = mag * sinf(ang);
        LAS bf16* colre = (LAS bf16*)(lds + (256 + dir * 128 + p) * 2); LAS bf16* colim = colre + 64;
        float Hr = 0.f, Hi = 0.f;
        for (int step = 0; step < 144; ++step) {
            const int j = dir == 0 ? step : (step < 16 ? 15 - step : 159 - step);
            LAS bf16* pr = (LAS bf16*)((LAS unsigned char*)colre + j * SS_AST); LAS bf16* pi = (LAS bf16*)((LAS unsigned char*)colim + j * SS_AST);
            const float sr = bf2f(*pr), si = bf2f(*pi);
            *pr = (bf16)f2bf(clamp16(Hr)); *pi = (bf16)f2bf(clamp16(Hi));
            const float nr = l16r * Hr - l16i * Hi + sr, ni = l16r * Hi + l16i * Hr + si; Hr = nr; Hi = ni;
        }
    }
    __syncthreads();
#pragma unroll
    for (int rt = 0; rt < 9; ++rt) { acc[rt][0] = (f32x4){0.f, 0.f, 0.f, 0.f}; acc[rt][1] = (f32x4){0.f, 0.f, 0.f, 0.f}; }
#pragma unroll
    for (int kh = 0; kh < 2; ++kh) {
#pragma unroll
        for (int ct = 0; ct < 2; ++ct)
#pragma unroll
            for (int ks = 0; ks < 8; ++ks) bfr[ct][ks] = *(const bf16x8*)(W2t + (size_t)(32 * w + 16 * ct + fr) * 512 + 256 * kh + 32 * ks + 8 * fq);
#pragma unroll
        for (int rt = 0; rt < 9; ++rt)
#pragma unroll
            for (int ks = 0; ks < 8; ++ks) { const bf16x8 a = *(const LAS bf16x8*)(lds + (16 * rt + fr) * SS_AST + (256 * kh + 32 * ks + 8 * fq) * 2);
                acc[rt][0] = MFMA16(a, bfr[0][ks], acc[rt][0]);
                acc[rt][1] = MFMA16(a, bfr[1][ks], acc[rt][1]); }
    }
    const float dsk = dskip[16 * g + fr];
#pragma unroll
    for (int rt = 0; rt < 9; ++rt)
#pragma unroll
        for (int ct = 0; ct < 2; ++ct) { const int t = 2 * w + ct;
#pragma unroll
            for (int r = 0; r < 4; ++r) { const int j = 16 * rt + 4 * fq + r;
                const float u = bf2f(*(const LAS bf16*)(lds + j * SS_AST + (16 * t + fr) * 2));
                const float y = acc[rt][ct][r] + dsk * u;
                gout[(size_t)ssm_row(b, j, t) * D + 16 * g + fr] = (bf16)f2bf(clamp16(gelu_tanh_f(y))); } }
    __syncthreads();
}

__device__ __forceinline__ void ssm_build(LAS unsigned char* lds, int g, const float* are, const float* aim, const float* logdt, const float* bre, const float* bim,
                                          const float* cre, const float* cim, bf16* W1t, bf16* W2t) {
    int tid_ = threadIdx.x; asm volatile("" : "+v"(tid_)); const int tid = tid_;
    LAS float* Lp = (LAS float*)lds;
    LAS float* Bb = Lp + 2 * 17 * 64 * 2;
    LAS float* Cc = Bb + 2 * 64 * 16 * 2;
    LAS float* Kk = Cc + 2 * 16 * 64 * 2;
    for (int id = tid; id < 2 * 17 * 64; id += 512) { const int p = id & 63, k = (id >> 6) % 17, dir = id / (17 * 64); const int gp = (dir * 64 + g) * 64 + p;
        const float lre = fminf(are[gp], -1e-4f), lim = aim[gp], dt = expf(logdt[dir * 64 + g]);
        const float mag = expf((float)k * lre * dt), ang = (float)k * lim * dt;
        Lp[id * 2] = mag * cosf(ang); Lp[id * 2 + 1] = mag * sinf(ang); }
    for (int id = tid; id < 2 * 64 * 16; id += 512) { const int c = id & 15, p = (id >> 4) & 63, dir = id >> 10; const int gp = (dir * 64 + g) * 64 + p;
        const float lre = fminf(are[gp], -1e-4f), lim = aim[gp], dt = expf(logdt[dir * 64 + g]);
        const float mag = expf(lre * dt), lbr = mag * cosf(lim * dt), lbi = mag * sinf(lim * dt);
        const float nr = lbr - 1.f, ni = lbi, den = lre * lre + lim * lim;
        const float cfr = (nr * lre + ni * lim) / den, cfi = (ni * lre - nr * lim) / den;
        const float br = bre[(size_t)gp * 16 + c], bi = bim[(size_t)gp * 16 + c];
        Bb[id * 2] = cfr * br - cfi * bi; Bb[id * 2 + 1] = cfr * bi + cfi * br; }
    for (int id = tid; id < 2 * 16 * 64; id += 512) { const int p = id & 63, c = (id >> 6) & 15, dir = id >> 10; const size_t src = ((size_t)(dir * 64 + g) * 16 + c) * 64 + p;
        Cc[id * 2] = cre[src]; Cc[id * 2 + 1] = cim[src]; }
    __syncthreads();
    for (int id = tid; id < 2 * 16 * 256; id += 512) { const int ci = id & 15, co = (id >> 4) & 15, d = (id >> 8) & 15, dir = id >> 12;
        float s = 0.f;
        for (int p = 0; p < 64; ++p) { const int li = ((dir * 17 + d) * 64 + p) * 2, bi_ = ((dir * 64 + p) * 16 + ci) * 2, ci_ = ((dir * 16 + co) * 64 + p) * 2;
            const float lr = Lp[li], lim_ = Lp[li + 1], br = Bb[bi_], bim_ = Bb[bi_ + 1], cr = Cc[ci_], cim_ = Cc[ci_ + 1];
            const float xr = lr * br - lim_ * bim_, xi = lr * bim_ + lim_ * br;
            s += cr * xr - cim_ * xi; }
        Kk[id] = s; }
    __syncthreads();
    for (int id = tid; id < 256 * 256; id += 512) { const int k = id & 255, n = id >> 8; const int s = k >> 4, c = k & 15, dir = n >> 7, part = (n >> 6) & 1, p = n & 63;
        const int e = dir == 0 ? 15 - s : s; const int li = ((dir * 17 + e) * 64 + p) * 2, bi_ = ((dir * 64 + p) * 16 + c) * 2;
        const float lr = Lp[li], lim_ = Lp[li + 1], br = Bb[bi_], bim_ = Bb[bi_ + 1];
        const float v = part == 0 ? lr * br - lim_ * bim_ : lr * bim_ + lim_ * br;
        W1t[id] = (bf16)f2bf(v); }
    for (int id = tid; id < 256 * 512; id += 512) { const int k = id & 511, n = id >> 9; const int t = n >> 4, co = n & 15; float v;
        if (k < 256) { const int s = k >> 4, ci = k & 15; v = 0.f;
            if (s <= t) v += Kk[((0 * 16 + (t - s)) * 16 + co) * 16 + ci];
            if (s >= t) v += Kk[((1 * 16 + (s - t)) * 16 + co) * 16 + ci]; }
        else { const int kk = k - 256, dir = kk >> 7, part = (kk >> 6) & 1, p = kk & 63; const int e = dir == 0 ? t + 1 : 16 - t;
            const int li = ((dir * 17 + e) * 64 + p) * 2, ci_ = ((dir * 16 + co) * 64 + p) * 2;
            const float lr = Lp[li], lim_ = Lp[li + 1], cr = Cc[ci_], cim_ = Cc[ci_ + 1];
            v = part == 0 ? cr * lr - cim_ * lim_ : -(cr * lim_ + cim_ * lr); }
        W2t[id] = (bf16)f2bf(v); }
    __syncthreads();
}
struct Ctx {
    LAS unsigned char* lds; int tid, lane, wave, G, bx, gw, ngw;
    const float* const* in; float* out; unsigned char* ws; unsigned* ctl;
    float* modv; float* h; bf16* xn;
};
__device__ __forceinline__ void load_row_f32(const float* p, int lane, f32x4 (&v)[4]) {
#pragma unroll
    for (int j = 0; j < 4; ++j) v[j] = ((const f32x4*)p)[lane + 64 * j];
}
__device__ __forceinline__ void load_row_bf16(const bf16* p, int lane, f32x4 (&v)[4]) {
#pragma unroll
    for (int j = 0; j < 4; ++j) { const u32x2 w = ((const u32x2*)p)[lane + 64 * j]; v[j] = (f32x4){bflo(w.x), bfhi(w.x), bflo(w.y), bfhi(w.y)}; }
}
__device__ __forceinline__ void store_row_bf16(bf16* p, int lane, const f32x4 (&v)[4]) {
#pragma unroll
    for (int j = 0; j < 4; ++j) { u32x2 w; w.x = pk2(v[j][0], v[j][1]); w.y = pk2(v[j][2], v[j][3]); ((u32x2*)p)[lane + 64 * j] = w; }
}
__device__ __forceinline__ float row_ss(const f32x4 (&v)[4]) {
    float s = 0.f;
#pragma unroll
    for (int j = 0; j < 4; ++j) s += (v[j][0] * v[j][0] + v[j][1] * v[j][1]) + (v[j][2] * v[j][2] + v[j][3] * v[j][3]);
    return wave_sum(s);
}
__device__ __forceinline__ void phase_t1(const Ctx& C, int L, bool pending) {
    const float* x = C.in[0]; const float* cx = C.in[2];
    const bf16* ys = (const bf16*)(C.ws + WS_YS); const int* rslot = (const int*)(C.ws + WS_TAB + TAB_ROUTE_S);
    const int nrows = (L == 4) ? NLAT : NROWS;
    for (int r = C.gw; r < nrows; r += C.ngw) {
        const int mr = mrow_of(r);
        f32x4 v[4];
        if (L == 0) load_row_f32(r < NLAT ? x + (size_t)r * D : cx + (size_t)(r - NLAT) * D, C.lane, v);
        else load_row_f32(C.h + (size_t)r * D, C.lane, v);
        if (L > 0 && pending) {
            const int s1 = rslot[2 * r], s2 = rslot[2 * r + 1];
            f32x4 y1[4], y2[4], g5[4];
            load_row_bf16(ys + (size_t)s1 * D, C.lane, y1); load_row_bf16(ys + (size_t)s2 * D, C.lane, y2);
            load_row_f32(C.modv + ((size_t)(L - 1) * 9 + mr) * 6144 + 5 * 1024, C.lane, g5);
#pragma unroll
            for (int j = 0; j < 4; ++j) v[j] = v[j] + g5[j] * (y1[j] + y2[j]);
        }
        if (L < 4 && (L == 0 || pending)) {
#pragma unroll
            for (int j = 0; j < 4; ++j) ((f32x4*)(C.h + (size_t)r * D))[C.lane + 64 * j] = v[j];
        }
        const float rs = rsqrtf(row_ss(v) * (1.f / D) + 1e-6f);
        if (L == 4) {
            f32x4 g[4]; load_row_f32(C.in[8], C.lane, g);
#pragma unroll
            for (int j = 0; j < 4; ++j) ((f32x4*)(C.out + (size_t)r * D))[C.lane + 64 * j] = v[j] * rs * g[j];
        } else {
            f32x4 g[4], sh[4], sc[4]; load_row_f32(C.in[6] + L * D, C.lane, g);
            const float* ml = C.modv + ((size_t)L * 9 + mr) * 6144; load_row_f32(ml, C.lane, sh); load_row_f32(ml + 1024, C.lane, sc);
            f32x4 o[4];
#pragma unroll
            for (int j = 0; j < 4; ++j) o[j] = v[j] * rs * g[j] * (sc[j] + 1.f) + sh[j];
            store_row_bf16(C.xn + (size_t)r * D, C.lane, o);
#ifdef MK_DEBUG_XN_F32
            { float* dbg = (float*)(C.ws + 3 * MiB);
#pragma unroll
              for (int j = 0; j < 4; ++j) ((f32x4*)(dbg + (size_t)r * D))[C.lane + 64 * j] = o[j]; }
#endif
        }
    }
}
__device__ __forceinline__ void phase_t2(const Ctx& C, int L) {
    const int nrows = (L == 3) ? NLAT : NROWS;
    const float* gw = C.in[28] + (size_t)L * 4096; const float* gb = C.in[29] + L * 4; const float* rw = C.in[30] + (size_t)L * 32768; const float* rb = C.in[31] + L * 32;
    LAS float* rwl = (LAS float*)C.lds;
    for (int i = C.tid; i < 8192; i += 512) ((LAS f32x4*)rwl)[i] = ((const f32x4*)rw)[i];
    f32x4 gwr[4][4];
#pragma unroll
    for (int j = 0; j < 4; ++j)
#pragma unroll
        for (int e = 0; e < 4; ++e) gwr[j][e] = ((const f32x4*)gw)[4 * C.lane + 256 * j + e];
    __syncthreads();
    int* ri = (int*)(C.ws + WS_TAB + TAB_ROUTE_I); float* rwt = (float*)(C.ws + WS_TAB + TAB_ROUTE_W);
    unsigned* cnt = C.ctl + CW_CNT + L * 32 * 64;
    for (int r = C.gw; r < nrows; r += C.ngw) {
        const int mr = mrow_of(r);
        f32x4 v[4]; load_row_f32(C.h + (size_t)r * D, C.lane, v);
        const float rs = rsqrtf(row_ss(v) * (1.f / D) + 1e-6f);
        f32x4 g[4], sh[4], sc[4]; load_row_f32(C.in[7] + L * D, C.lane, g);
        const float* ml = C.modv + ((size_t)L * 9 + mr) * 6144; load_row_f32(ml + 3 * 1024, C.lane, sh); load_row_f32(ml + 4 * 1024, C.lane, sc);
        f32x4 xm[4];
#pragma unroll
        for (int j = 0; j < 4; ++j) xm[j] = v[j] * rs * g[j] * (sc[j] + 1.f) + sh[j];
        store_row_bf16(C.xn + (size_t)r * D, C.lane, xm);
        f32x4 gl = {0.f, 0.f, 0.f, 0.f};
#pragma unroll
        for (int j = 0; j < 4; ++j)
#pragma unroll
            for (int e = 0; e < 4; ++e) gl = gl + gwr[j][e] * xm[j][e];
        float g0 = wave_sum(gl[0]) + gb[0], g1 = wave_sum(gl[1]) + gb[1], g2 = wave_sum(gl[2]) + gb[2], g3 = wave_sum(gl[3]) + gb[3];
        int gi = 0; float gm = g0;
        if (g1 > gm) { gm = g1; gi = 1; } if (g2 > gm) { gm = g2; gi = 2; } if (g3 > gm) { gm = g3; gi = 3; }
        const float pg = 1.f / (__expf(g0 - gm) + __expf(g1 - gm) + __expf(g2 - gm) + __expf(g3 - gm));
        f32x4 ea = {0.f, 0.f, 0.f, 0.f}, eb = {0.f, 0.f, 0.f, 0.f};
        const LAS float* rp = rwl + (size_t)gi * 8192;
#pragma unroll
        for (int j = 0; j < 4; ++j)
#pragma unroll
            for (int e = 0; e < 4; ++e) { const int col = 4 * C.lane + 256 * j + e; const f32x4 w0 = *(const LAS f32x4*)(rp + col * 8), w1 = *(const LAS f32x4*)(rp + col * 8 + 4);
                ea = ea + w0 * xm[j][e]; eb = eb + w1 * xm[j][e]; }
        float el[8];
#pragma unroll
        for (int e = 0; e < 4; ++e) { el[e] = wave_sum(ea[e]) + rb[gi * 8 + e]; el[4 + e] = wave_sum(eb[e]) + rb[gi * 8 + 4 + e]; }
        int e1 = 0; float v1 = el[0];
#pragma unroll
        for (int e = 1; e < 8; ++e) if (el[e] > v1) { v1 = el[e]; e1 = e; }
        int e2 = -1; float v2 = -3.4e38f;
#pragma unroll
        for (int e = 0; e < 8; ++e) if (e != e1 && el[e] > v2) { v2 = el[e]; e2 = e; }
        const float ex = __expf(v2 - v1); const float w1 = pg / (1.f + ex), w2 = pg * ex / (1.f + ex);
        if (C.lane == 0) {
            const int ge1 = gi * 8 + e1, ge2 = gi * 8 + e2;
            const unsigned p1 = atomicAdd(cnt + ge1 * 64, 1u), p2 = atomicAdd(cnt + ge2 * 64, 1u);
            ri[4 * r] = ge1; ri[4 * r + 1] = (int)p1; ri[4 * r + 2] = ge2; ri[4 * r + 3] = (int)p2; rwt[2 * r] = w1; rwt[2 * r + 1] = w2;
        }
    }
    __syncthreads();
}
__device__ __forceinline__ void phase_t3(const Ctx& C, int L) {
    const int nrows = (L == 3) ? NLAT : NROWS;
    LAS int* toff = (LAS int*)C.lds;
    unsigned* cnt = C.ctl + CW_CNT + L * 32 * 64; unsigned* tbl = C.ctl + CW_TILE + L * 256;
    if (C.tid == 0) { int acc = 0; for (int e = 0; e < 32; ++e) { toff[e] = acc; acc += ((int)ld_agent(cnt + e * 64) + 255) >> 8; } toff[32] = acc; }
    __syncthreads();
    if (C.bx == 0) {
        if (C.tid == 0) tbl[0] = (unsigned)toff[32];
        if (C.tid < 32) { for (int t = toff[C.tid]; t < toff[C.tid + 1]; ++t) tbl[1 + t] = (unsigned)C.tid; }
    }
    const int* ri = (const int*)(C.ws + WS_TAB + TAB_ROUTE_I); const float* rwt = (const float*)(C.ws + WS_TAB + TAB_ROUTE_W);
    int* rslot = (int*)(C.ws + WS_TAB + TAB_ROUTE_S); float* wslot = (float*)(C.ws + WS_TAB + TAB_WSLOT);
    bf16* xs = (bf16*)(C.ws + WS_XS);
    for (int r = C.gw; r < nrows; r += C.ngw) {
        const int e1 = ri[4 * r], p1 = ri[4 * r + 1], e2 = ri[4 * r + 2], p2 = ri[4 * r + 3];
        const int s1 = toff[e1] * 256 + p1, s2 = toff[e2] * 256 + p2;
        u32x2 w[4];
#pragma unroll
        for (int j = 0; j < 4; ++j) w[j] = ((const u32x2*)(C.xn + (size_t)r * D))[C.lane + 64 * j];
#pragma unroll
        for (int j = 0; j < 4; ++j) { ((u32x2*)(xs + (size_t)s1 * D))[C.lane + 64 * j] = w[j]; ((u32x2*)(xs + (size_t)s2 * D))[C.lane + 64 * j] = w[j]; }
        if (C.lane == 0) { rslot[2 * r] = s1; rslot[2 * r + 1] = s2; wslot[s1] = rwt[2 * r]; wslot[s2] = rwt[2 * r + 1]; }
    }
    __syncthreads();
}
__device__ __forceinline__ void phase_diffcombine(const Ctx& C, int i, float lambda_init) {
    const float* lq1 = C.in[13] + i * 64; const float* lk1 = C.in[14] + i * 64; const float* lq2 = C.in[15] + i * 64; const float* lk2 = C.in[16] + i * 64; const float* subg = C.in[17] + i * 128;
    const float lam = __expf(wave_sum(lq1[C.lane] * lk1[C.lane])) - __expf(wave_sum(lq2[C.lane] * lk2[C.lane])) + lambda_init;
    const float* o12 = (const float*)(C.ws + WS_O12); bf16* merged = (bf16*)(C.ws + WS_MERGED);
    const f32x2 sg = *(const f32x2*)(subg + 2 * C.lane);
    for (int r = C.gw; r < NROWS; r += C.ngw) {
#pragma unroll
        for (int hd = 0; hd < 4; ++hd) {
            const f32x2 a = *(const f32x2*)(o12 + (size_t)r * D + hd * 256 + 2 * C.lane), bq = *(const f32x2*)(o12 + (size_t)r * D + hd * 256 + 128 + 2 * C.lane);
            const f32x2 ob = a - bq * lam;
            const float rs = rsqrtf(wave_sum(ob[0] * ob[0] + ob[1] * ob[1]) * (1.f / 128.f) + 1e-6f) * (1.f - lambda_init);
            *(unsigned*)(merged + (size_t)r * D + 512 + hd * 128 + 2 * C.lane) = pk2(ob[0] * rs * sg[0], ob[1] * rs * sg[1]);
        }
    }
}

__device__ __forceinline__ void p0_mod(const Ctx& C) {
    LAS float* sil = (LAS float*)C.lds;
    LAS float* red = sil + 9 * 1024;
    for (int i = C.tid; i < 9 * 1024; i += 512) { const int r = i >> 10, k = i & 1023; const float v = r < 8 ? C.in[1][r * 1024 + k] : C.in[3][k]; sil[i] = v / (1.f + __expf(-v)); }
    __syncthreads();
    for (int it = C.bx; it < 4 * 96; it += C.G) {
        const int l = it / 96, j0 = (it % 96) * 64;
        const float* w = C.in[4] + ((size_t)l * 1024 + C.wave * 128) * 6144 + j0 + C.lane;
        float a[9];
#pragma unroll
        for (int r = 0; r < 9; ++r) a[r] = 0.f;
#pragma unroll 8
        for (int k = 0; k < 128; ++k) { const float wv = w[(size_t)k * 6144];
#pragma unroll
            for (int r = 0; r < 9; ++r) a[r] += sil[r * 1024 + C.wave * 128 + k] * wv; }
#pragma unroll
        for (int r = 0; r < 9; ++r) red[(C.wave * 9 + r) * 64 + C.lane] = a[r];
        __syncthreads();
        for (int o = C.tid; o < 9 * 64; o += 512) { const int r = o >> 6, c = o & 63; float s = 0.f;
#pragma unroll
            for (int wv = 0; wv < 8; ++wv) s += red[(wv * 9 + r) * 64 + c];
            C.modv[((size_t)l * 9 + r) * 6144 + j0 + c] = s + C.in[5][l * 6144 + j0 + c]; }
        __syncthreads();
    }
}
template <class RowMap>
__device__ __forceinline__ void p0_transpose_item(const float* W, int K, int N, bf16* WT, const RowMap& rm, LAS float* scr, int item, int lane) {
    const int nblk = N / 32, kb = item / nblk, nb = item % nblk, k0 = 64 * kb, n0 = 32 * nb;
#pragma unroll 8
    for (int i = 0; i < 32; ++i) { const int kk = 2 * i + (lane >> 5); scr[kk * 33 + (lane & 31)] = W[(size_t)(k0 + kk) * N + n0 + (lane & 31)]; }
    asm volatile("s_waitcnt lgkmcnt(0)" ::: "memory");
    const int c = lane & 7;
#pragma unroll
    for (int j = 0; j < 4; ++j) { const int n = (lane >> 3) + 8 * j; const LAS float* s = scr + (8 * c) * 33 + n;
        u32x4 o; o.x = pk2(s[0 * 33], s[1 * 33]); o.y = pk2(s[2 * 33], s[3 * 33]); o.z = pk2(s[4 * 33], s[5 * 33]); o.w = pk2(s[6 * 33], s[7 * 33]);
        *(u32x4*)(WT + (size_t)rm(n0 + n) * K + k0 + 8 * c) = o; }
    asm volatile("s_waitcnt lgkmcnt(0)" ::: "memory");
}
struct MapId { int off; __device__ __forceinline__ int operator()(int n) const { return off + n; } };
struct MapQKV { __device__ __forceinline__ int operator()(int n) const { const int hs = n >> 6, d = n & 63; const int bj = d >> 5, dd = d & 31, ni = dd >> 4, fq = (dd & 15) >> 2, j = dd & 3;
    return 256 * (hs >> 2) + 128 * bj + 32 * (hs & 3) + 8 * fq + 4 * ni + j; } };
struct MapIlv { int base, which; __device__ __forceinline__ int operator()(int o) const {
    return base + 256 * (o >> 7) + 128 * ((o & 127) >> 6) + 32 * ((o & 63) >> 4) + 8 * ((o & 15) >> 2) + 4 * which + (o & 3); } };

__device__ __forceinline__ void p0_convert(const Ctx& C) {
    LAS float* scr = (LAS float*)(C.lds + C.wave * 16384);
    bf16* Wqkv = (bf16*)(C.ws + WS_WQKV); bf16* Wo = (bf16*)(C.ws + WS_WO); bf16* Wglu = (bf16*)(C.ws + WS_WGLU); bf16* Wgu = (bf16*)(C.ws + WS_WGU); bf16* Wd = (bf16*)(C.ws + WS_WD);
    constexpr int I_QKV = 16 * 72, I_SQ = 16 * 32, I_G = 16 * 8, I_DN = 4 * 32;
    constexpr int N0 = 2 * I_QKV, N1 = N0 + 2 * I_SQ, N2 = N1 + 4 * I_SQ, N3 = N2 + 256 * I_G, N4 = N3 + 128 * I_DN;
    for (int it = C.gw; it < N4; it += C.ngw) {
        if (it < N0) { const int i = it / I_QKV, r = it % I_QKV; p0_transpose_item(C.in[9] + (size_t)i * D * 2304, D, 2304, Wqkv + (size_t)i * 2304 * D, MapQKV{}, scr, r, C.lane); }
        else if (it < N1) { const int q = it - N0, i = q / I_SQ, r = q % I_SQ; p0_transpose_item(C.in[10] + (size_t)i * D * D, D, D, Wo + (size_t)i * D * D, MapId{0}, scr, r, C.lane); }
        else if (it < N2) { const int q = it - N1, mi = q / I_SQ, r = q % I_SQ, i = mi >> 1, wh = mi & 1;
            p0_transpose_item((wh ? C.in[27] : C.in[26]) + (size_t)i * D * D, D, D, Wglu + (size_t)i * 2048 * D, MapIlv{0, wh}, scr, r, C.lane); }
        else if (it < N3) { const int q = it - N2, mi = q / I_G, r = q % I_G, wh = mi & 1, le = mi >> 1;
            p0_transpose_item((wh ? C.in[33] : C.in[32]) + (size_t)le * D * 256, D, 256, Wgu + (size_t)le * 512 * D, MapIlv{0, wh}, scr, r, C.lane); }
        else { const int q = it - N3, le = q / I_DN, r = q % I_DN;
            p0_transpose_item(C.in[34] + (size_t)le * 256 * D, 256, D, Wd + (size_t)le * D * 256, MapId{0}, scr, r, C.lane); }
    }
}
__device__ __forceinline__ void p0_misc(const Ctx& C) {
    if (C.bx == C.G - 1) {
        float* tab = (float*)(C.ws + WS_TAB);
        for (int i = C.tid; i < 1024; i += 512) { const int pos = i >> 4, f = i & 15; const float inv = powf(10000.f, -(float)f / 16.f); const float ang = (float)pos * inv;
            tab[2 * i] = cosf(ang); tab[2 * i + 1] = sinf(ang); }
    }
    __syncthreads();
    for (int u = C.bx; u < 128; u += C.G) { const int i = u >> 6, g = u & 63;
        ssm_build(C.lds, g, C.in[18] + (size_t)i * 8192, C.in[19] + (size_t)i * 8192, C.in[20] + i * 128, C.in[21] + (size_t)i * 131072, C.in[22] + (size_t)i * 131072,
                  C.in[23] + (size_t)i * 131072, C.in[24] + (size_t)i * 131072,
                  (bf16*)(C.ws + WS_SSM) + ((size_t)i * 64 + g) * 65536, (bf16*)(C.ws + WS_SSM + 16 * MiB) + ((size_t)i * 64 + g) * 131072); }
}
constexpr int N_PHASES = 42;
struct Args { const float* in[35]; float* out; unsigned char* ws; int ph_lo, ph_hi, use_bar, pending; };
static_assert(sizeof(Args) == 35 * 8 + 8 + 8 + 16, "Args has no padding");

__device__ __forceinline__ Ctx make_ctx(const Args& a, unsigned char* lds_raw) {
    Ctx C;
    C.lds = (LAS unsigned char*)lds_raw;
    int tid_ = threadIdx.x; asm volatile("" : "+v"(tid_));
    C.tid = tid_; C.lane = C.tid & 63; C.wave = __builtin_amdgcn_readfirstlane(C.tid >> 6);
    int bx_ = blockIdx.x; asm volatile("" : "+s"(bx_));
    C.G = gridDim.x; C.bx = bx_; C.gw = bx_ * 8 + C.wave; C.ngw = C.G * 8;
    unsigned long long w = (unsigned long long)a.ws, o = (unsigned long long)a.out;
    asm volatile("" : "+s"(w), "+s"(o));
    C.in = a.in; C.out = (float*)o; C.ws = (unsigned char*)w; C.ctl = (unsigned*)(C.ws + WS_CTL);
    C.modv = (float*)(C.ws + WS_MODV); C.h = (float*)(C.ws + WS_H); C.xn = (bf16*)(C.ws + WS_XN);
    return C;
}
#define PHASE_CTX() C = make_ctx(a, lds_raw); ws = C.ws; bx = C.bx; Qb = (bf16*)(ws + WS_Q); Kb = (bf16*)(ws + WS_K); Vb = (bf16*)(ws + WS_V); merged = (bf16*)(ws + WS_MERGED); o12 = (float*)(ws + WS_O12)
__global__ void __launch_bounds__(512, 2) mk_fwd(Args a) {
    extern __shared__ __attribute__((aligned(16))) unsigned char lds_raw[];
    Ctx C = make_ctx(a, lds_raw);
    if (C.tid < 64) ((LAS unsigned*)(C.lds + LDS_BARW))[C.tid] = 0u;
    __syncthreads();
    XcdBarrier bar; bar.bar = C.ctl + CW_BAR; bar.x = 0; bar.st = (volatile LAS unsigned*)(C.lds + LDS_BARW);
    if (a.use_bar) { bar = xcd_barrier_post(C.ctl + CW_BAR, (volatile LAS unsigned*)(C.lds + LDS_BARW)); xcd_barrier<true>(bar); }
    const int lo = a.ph_lo, hi = a.ph_hi;
#define IN(k) (lo <= (k) && (k) < hi)
#define SEAM() do { if (a.use_bar) { XcdBarrier bl_ = bar; asm volatile("" : "+s"(bl_.x)); xcd_barrier<false>(bl_); } } while (0)
    int bx;
    unsigned char* ws; bf16 *Qb, *Kb, *Vb, *merged; float* o12;

    if (IN(0)) { PHASE_CTX(); p0_mod(C); p0_convert(C); p0_misc(C); SEAM(); }

    for (int L = 0; L < 4; ++L) {
        const int pb = 1 + 10 * L, i = L >> 1;
        if (IN(pb)) { PHASE_CTX(); phase_t1(C, L, a.pending != 0 || lo < pb); SEAM(); }
        if ((L & 1) == 0) {
            if (IN(pb + 1)) { PHASE_CTX();
                pg8::Gemm g{C.xn, (const bf16*)(ws + WS_WQKV) + (size_t)i * 2304 * D, NROWS, 2304, D}; pg8::StaticOrder S; S.init(NROWS, 2304, C.G, bx);
                EpiQKV E{Qb, Kb, Vb, C.in[11] + i * 64, C.in[12] + i * 64, (const float*)(ws + WS_TAB)};
                pg8::gemm_phase<EpiQKV, pg8::StaticOrder, true, true>(C.lds, g, S, E);
                SEAM();
            }
            if (IN(pb + 2)) { PHASE_CTX();
                for (int ui = bx; ui < 1152; ui += C.G) {
                    int b, qrow0, qcol, kcol, vcol, ocol; bool lat, vd64;
                    if (ui < 512) { const int vh = ui & 7, qb = (ui >> 3) & 7; b = ui >> 6; lat = true; vd64 = true; qrow0 = b * 2048 + qb * 256; qcol = 64 * vh; kcol = 64 * (vh >> 2); vcol = kcol; ocol = 64 * vh; }
                    else if (ui < 1024) { const int u2 = ui - 512, v8 = u2 & 7, qb = (u2 >> 3) & 7; b = u2 >> 6; lat = true; vd64 = false; qrow0 = b * 2048 + qb * 256; qcol = 512 + 64 * v8; kcol = 128 + 64 * v8; vcol = 128 + 128 * (v8 >> 1); ocol = 128 * v8; }
                    else { const int u3 = ui - 1024, vh = u3 & 15; b = u3 >> 4; lat = false; qrow0 = NLAT + b * 256;
                        if (vh < 8) { vd64 = true; qcol = 64 * vh; kcol = 64 * (vh >> 2); vcol = kcol; ocol = 64 * vh; }
                        else { const int v8 = vh - 8; vd64 = false; qcol = 512 + 64 * v8; kcol = 128 + 64 * v8; vcol = 128 + 128 * (v8 >> 1); ocol = 128 * v8; } }
                    if (vd64) attn_unit<64>(C.lds, Qb, Kb, Vb, merged, o12, b, qrow0, lat, qcol, kcol, vcol, ocol);
                    else attn_unit<128>(C.lds, Qb, Kb, Vb, merged, o12, b, qrow0, lat, qcol, kcol, vcol, ocol);
                }
                SEAM();
            }
            if (IN(pb + 3)) { PHASE_CTX(); phase_diffcombine(C, i, L == 0 ? 0.2f : 0.47071303f);     SEAM(); }
            if (IN(pb + 4)) { PHASE_CTX();
                pg8::Gemm g{merged, (const bf16*)(ws + WS_WO) + (size_t)i * D * D, NROWS, D, D}; pg8::StaticOrder S; S.init(NROWS, D, C.G, bx);
                EpiResid E{C.h, C.modv + (size_t)L * 9 * 6144 + 2 * 1024};
                pg8::gemm_phase<EpiResid, pg8::StaticOrder, true, true>(C.lds, g, S, E);
                SEAM();
            }
        } else {
            if (IN(pb + 1)) { PHASE_CTX();
                for (int u = bx; u < 512; u += C.G) { const int g = u >> 3, b = u & 7;
                    ssm_unit(C.lds, b, g, C.xn, merged, (const bf16*)(ws + WS_SSM) + ((size_t)i * 64 + g) * 65536, (const bf16*)(ws + WS_SSM + 16 * MiB) + ((size_t)i * 64 + g) * 131072,
                             C.in[18] + (size_t)i * 8192, C.in[19] + (size_t)i * 8192, C.in[20] + i * 128, C.in[25] + i * D); }
                SEAM();
            }
            if (IN(pb + 4)) { PHASE_CTX();
                const int M = (L == 3) ? NLAT : NROWS;
                pg8::Gemm g{merged, (const bf16*)(ws + WS_WGLU) + (size_t)i * 2048 * D, M, 2048, D}; pg8::StaticOrder S; S.init(M, 2048, C.G, bx);
                EpiGLU E{C.h, C.modv + (size_t)L * 9 * 6144 + 2 * 1024};
                pg8::gemm_phase<EpiGLU, pg8::StaticOrder, true, true>(C.lds, g, S, E);
                SEAM();
            }
        }
        if (IN(pb + 5)) { PHASE_CTX(); phase_t2(C, L); SEAM(); }
        if (IN(pb + 6)) { PHASE_CTX(); phase_t3(C, L); SEAM(); }
        if (IN(pb + 7)) { PHASE_CTX();
            pg8::Gemm g{(const bf16*)(ws + WS_XS), (const bf16*)(ws + WS_WGU) + (size_t)L * 32 * 512 * D, 0, 0, D}; MoeOrder S{C.ctl + CW_TILE + L * 256, 2, C.G, bx};
            EpiGateUp E{(bf16*)(ws + WS_HID), (const float*)(ws + WS_TAB + TAB_WSLOT)};
            pg8::gemm_phase<EpiGateUp, MoeOrder, true, true>(C.lds, g, S, E);
            SEAM();
        }
        if (IN(pb + 8)) { PHASE_CTX(); int kdown = 256; asm volatile("" : "+s"(kdown));
            pg8::Gemm g{(const bf16*)(ws + WS_HID), (const bf16*)(ws + WS_WD) + (size_t)L * 32 * D * 256, 0, 0, kdown}; MoeOrder S{C.ctl + CW_TILE + L * 256, 4, C.G, bx};
            EpiDown E{(bf16*)(ws + WS_YS)};
            pg8::gemm_phase<EpiDown, MoeOrder, true, true>(C.lds, g, S, E);
            SEAM();
        }
    }
    if (IN(41)) { PHASE_CTX(); phase_t1(C, 4, true); }
#undef IN
#undef SEAM
}

static bool phase_exists(int p) {
    if (p == 0 || p == 41) return true;
    const int L = (p - 1) / 10, k = (p - 1) % 10;
    if (k == 9) return false;
    if ((L & 1) && (k == 2 || k == 3)) return false;
    return true;
}
static void mk_run(void* const* d_in, float* out, unsigned char* ws, hipStream_t stream, int lo, int hi, bool one_launch, int pending) {
    static int grid = 0;
    if (grid == 0) {
        int dev = 0, cus = 0, per_cu = 0;
        if (hipGetDevice(&dev) != hipSuccess || hipDeviceGetAttribute(&cus, hipDeviceAttributeMultiprocessorCount, dev) != hipSuccess) { grid = -1; return; }
        if (hipFuncSetAttribute((const void*)mk_fwd, hipFuncAttributeMaxDynamicSharedMemorySize, LDS_BYTES) != hipSuccess) { fprintf(stderr, "mk: hipFuncSetAttribute failed\n"); grid = -1; return; }
        if (hipOccupancyMaxActiveBlocksPerMultiprocessor(&per_cu, (const void*)mk_fwd, 512, LDS_BYTES) != hipSuccess || per_cu < 1) { fprintf(stderr, "mk: occupancy query says %d\n", per_cu); }
        (void)hipGetLastError();
        grid = cus;
    }
    if (grid < 0) return;
    Args a{};
    for (int i = 0; i < 35; ++i) a.in[i] = (const float*)d_in[i];
    a.out = out; a.ws = ws; a.pending = pending;
    if (one_launch) { a.ph_lo = lo; a.ph_hi = hi; a.use_bar = 1; hipLaunchKernelGGL(mk_fwd, dim3(grid), dim3(512), LDS_BYTES, stream, a); }
    else for (int p = lo; p < hi; ++p) if (phase_exists(p)) { a.ph_lo = p; a.ph_hi = p + 1; a.use_bar = 0; hipLaunchKernelGGL(mk_fwd, dim3(grid), dim3(512), LDS_BYTES, stream, a); }
}
#ifndef MK_ONE_LAUNCH
#define MK_ONE_LAUNCH 1
#endif
extern "C" void kernel_launch(void* const* d_in, const int* in_sizes, int n_in, void* d_out, int out_size, void* d_ws, size_t ws_size, hipStream_t stream) {
    if (n_in != 35 || ws_size < WS_END || out_size != NLAT * D) { fprintf(stderr, "kernel_launch: unexpected n_in %d / ws %zu / out %d\n", n_in, ws_size, out_size); return; }
    unsigned char* ws = (unsigned char*)d_ws;
    (void)hipMemsetAsync(ws + WS_CTL, 0, CTL_ZERO_BYTES, stream);
    mk_run(d_in, (float*)d_out, ws, stream, 0, N_PHASES, MK_ONE_LAUNCH != 0, 1);
}
```

```cpp
#include <hip/hip_runtime.h>
#include <cstdio>
#include <cstdint>
#define MK_ONE_LAUNCH 1
#ifndef MK_F16
#define MK_F16 1
#endif
#if MK_F16
#define PG8_MFMA(a, b, c) __builtin_amdgcn_mfma_f32_16x16x32_f16(__builtin_bit_cast(_Float16 __attribute__((ext_vector_type(8))), a), __builtin_bit_cast(_Float16 __attribute__((ext_vector_type(8))), b), c, 0, 0, 0)
#else
#define PG8_MFMA(a, b, c) __builtin_amdgcn_mfma_f32_16x16x32_bf16(a, b, c, 0, 0, 0)
#endif
namespace pg8 {
#define PG8_LAS __attribute__((address_space(3)))
typedef unsigned short bf16_t;
typedef short bf16x8 __attribute__((ext_vector_type(8)));
typedef float f32x4 __attribute__((ext_vector_type(4)));
typedef unsigned u32x4 __attribute__((ext_vector_type(4)));
constexpr int BM = 256, BK = 64, HALF = 128, HTB = HALF * BK * 2  , STAGE_BYTES = 8 * HTB, NXCD = 8, WGM = 8;

__host__ __device__ __forceinline__ int lds_byte(int r, int c) { const int st = (r >> 4) * 2 + (c >> 5), rr = r & 15, cc = c & 31, ob = rr * 64 + cc * 2; return st * 1024 + (ob ^ (((ob >> 9) & 1) << 5)); }
__host__ __device__ __forceinline__ void stage_rc(int b, int& R, int& C) { const int st = b / 1024, sb = b % 1024, swz = sb ^ (((sb >> 9) & 1) << 5); R = (st >> 1) * 16 + swz / 64; C = (st & 1) * 32 + (swz % 64) / 2; }
__host__ __device__ __forceinline__ int perm32(int rho) { const int n = rho >> 4, i = rho & 15; return 8 * (i >> 2) + 4 * n + (i & 3); }

struct Unit { int pm, pn; };
struct Gemm { const bf16_t* A; const bf16_t* Bt; int M, N, K; };

struct StaticOrder {
    int nM, nN, nwg, G, c;
    __host__ __device__ void init(int M, int N, int G_, int c_) { nM = M / BM; nN = N / BM; nwg = nM * nN; G = G_; c = c_; }
    __host__ __device__ bool next(int i, Unit& u) const {
        const long L = (long)i * G + c; if (L >= nwg) return false;
        int wgid = (int)L; { const int q = nwg / NXCD, r = nwg % NXCD, xcd = wgid % NXCD, off = wgid / NXCD; wgid = (xcd < r ? xcd * (q + 1) : r * (q + 1) + (xcd - r) * q) + off; }
        const int nig = WGM * nN, gid = wgid / nig, fm = gid * WGM, gsz = (nM - fm) < WGM ? (nM - fm) : WGM;
        u.pm = fm + ((wgid % nig) % gsz); u.pn = (wgid % nig) / gsz; return true;
    }
    __device__ __forceinline__ void a_ready(const Unit&) const {}
    __device__ __forceinline__ void done(const Unit&) const {}
};

__device__ __forceinline__ unsigned cvt_pk_bf16(float lo, float hi) { unsigned r; asm volatile("v_cvt_pk_bf16_f32 %0, %1, %2" : "=v"(r) : "v"(lo), "v"(hi)); return r; }
typedef float f32x2 __attribute__((ext_vector_type(2)));
template <class Epi, class Sched, bool ALIGN_EPI = false, bool SP2 = false>
__device__ __forceinline__ void gemm_phase(PG8_LAS unsigned char* lds, const Gemm g, const Sched& S, const Epi& E) {
    int tid_ = threadIdx.x; asm volatile("" : "+v"(tid_));
    const int tid = tid_, wid = __builtin_amdgcn_readfirstlane(tid >> 6), lane = tid & 63, wr = wid >> 2, wc = wid & 3, fr = lane & 15, fq = lane >> 4;
    const int K = g.K, nt = K / BK;
    unsigned voffA[2], voffB[2];
#pragma unroll
    for (int i = 0; i < 2; ++i) { int R, C; stage_rc(tid * 16 + i * 8192, R, C); const int Rb = Epi::PERM ? ((R & ~31) + perm32(R & 31)) : R;
        voffA[i] = (unsigned)(R * K + C) * 2u; voffB[i] = (unsigned)(Rb * K + C) * 2u; }
    const size_t kstep = (size_t)(BK * 2);
    const size_t hstep = (size_t)HALF * K * 2;
    const size_t tstep = 2 * hstep;
    const unsigned ldsw = (unsigned)wid * 1024u;
    const int aoff = lds_byte(wr * 64 + fr, fq * 8), boff = lds_byte(wc * 32 + fr, fq * 8);
#define PG8_SA(b, h) (((b) * 2 + (h)) * HTB)
#define PG8_SB(b, h) ((4 + (b) * 2 + (h)) * HTB)
#define PG8_STAGE(bufoff, gbase, voff) do { _Pragma("unroll") for (int _i = 0; _i < 2; ++_i) \
        __builtin_amdgcn_global_load_lds((const unsigned*)((const char*)(gbase) + (voff)[_i]), (PG8_LAS unsigned*)(lds + (bufoff) + ldsw + _i * 8192), 16, 0, 0); } while (0)
#define PG8_LDA(dst, b, h) do { _Pragma("unroll") for (int m = 0; m < 4; ++m) _Pragma("unroll") for (int k = 0; k < 2; ++k) dst[m][k] = *(const PG8_LAS bf16x8*)(lds + PG8_SA(b, h) + aoff + m * 2048 + k * 1024); } while (0)
#define PG8_LDB(dst, b, h) do { _Pragma("unroll") for (int n = 0; n < 2; ++n) _Pragma("unroll") for (int k = 0; k < 2; ++k) dst[n][k] = *(const PG8_LAS bf16x8*)(lds + PG8_SB(b, h) + boff + n * 2048 + k * 1024); } while (0)
#define PG8_MMA(ai, bj, At, Bt) do { __builtin_amdgcn_s_setprio(1); _Pragma("unroll") for (int m = 0; m < 4; ++m) _Pragma("unroll") for (int n = 0; n < 2; ++n) _Pragma("unroll") for (int k = 0; k < 2; ++k) \
        acc[ai][bj][m][n] = PG8_MFMA(Bt[n][k], At[m][k], acc[ai][bj][m][n]); __builtin_amdgcn_s_setprio(0); } while (0)
#define PG8_WAIT_V(n) asm volatile("s_waitcnt vmcnt(" #n ")" ::: "memory")
#define PG8_WAIT_L(n) asm volatile("s_waitcnt lgkmcnt(" #n ")" ::: "memory")
#define PG8_BAR __builtin_amdgcn_s_barrier()
#define PG8_SCHED __builtin_amdgcn_sched_barrier(0)
    Unit cur, nxt; int ui = 0;
    if (!S.next(0, cur)) return;
    f32x4 acc[2][2][4][2];
#pragma unroll
    for (int a = 0; a < 2; ++a)
#pragma unroll
        for (int b = 0; b < 2; ++b)
#pragma unroll
            for (int m = 0; m < 4; ++m)
#pragma unroll
                for (int n = 0; n < 2; ++n) acc[a][b][m][n] = (f32x4){0.f, 0.f, 0.f, 0.f};
    bf16x8 At[4][2], B0[2][2], B1[2][2];
    const char* cA = (const char*)g.A + (size_t)cur.pm * tstep; const char* cB = (const char*)g.Bt + (size_t)cur.pn * tstep;
    S.a_ready(cur);
    if constexpr (SP2) {
        PG8_STAGE(PG8_SB(0, 0), cB, voffB); PG8_STAGE(PG8_SB(0, 1), cB + hstep, voffB); PG8_STAGE(PG8_SA(0, 0), cA, voffA); PG8_STAGE(PG8_SA(0, 1), cA + hstep, voffA);
        if (wr == 1) PG8_BAR;
        PG8_WAIT_V(2); PG8_BAR;
        PG8_STAGE(PG8_SB(1, 0), cB + kstep, voffB); PG8_STAGE(PG8_SA(1, 0), cA + kstep, voffA); PG8_STAGE(PG8_SB(1, 1), cB + hstep + kstep, voffB);
        PG8_WAIT_V(6); PG8_BAR;
    } else {
        PG8_STAGE(PG8_SB(0, 0), cB, voffB); PG8_STAGE(PG8_SA(0, 0), cA, voffA); PG8_STAGE(PG8_SB(0, 1), cB + hstep, voffB); PG8_STAGE(PG8_SA(0, 1), cA + hstep, voffA);
        if (wr == 1) PG8_BAR;
        PG8_WAIT_V(4); PG8_BAR;
        PG8_STAGE(PG8_SB(1, 0), cB + kstep, voffB); PG8_STAGE(PG8_SA(1, 0), cA + kstep, voffA); PG8_STAGE(PG8_SB(1, 1), cB + hstep + kstep, voffB);
        PG8_WAIT_V(6); PG8_BAR;
    }
    for (;;) {
        const bool has_next = S.next(ui + 1, nxt);
        const char* nA = has_next ? (const char*)g.A + (size_t)nxt.pm * tstep : cA; const char* nB = has_next ? (const char*)g.Bt + (size_t)nxt.pn * tstep : cB;
        for (int t = 0; t < nt; t += 2) {
            const bool last = (t == nt - 2);
            const char* a1 = cA + (size_t)(t + 1) * kstep;
            const char* a2 = last ? nA : cA + (size_t)(t + 2) * kstep; const char* b2 = last ? nB : cB + (size_t)(t + 2) * kstep;
            const char* a3 = a2 + kstep; const char* b3 = b2 + kstep;
            if (last && has_next) S.a_ready(nxt);
            if constexpr (SP2) {
            PG8_LDB(B0, 0, 0); PG8_LDB(B1, 0, 1); PG8_SCHED; PG8_LDA(At, 0, 0); PG8_STAGE(PG8_SA(1, 1), a1 + hstep, voffA);
            PG8_WAIT_V(8); PG8_WAIT_L(0); PG8_BAR; PG8_MMA(0, 0, At, B0); PG8_MMA(0, 1, At, B1); PG8_BAR; PG8_SCHED;
            PG8_LDA(At, 0, 1); PG8_STAGE(PG8_SB(0, 0), b2, voffB); PG8_STAGE(PG8_SB(0, 1), b2 + hstep, voffB); PG8_STAGE(PG8_SA(0, 0), a2, voffA);
            PG8_WAIT_V(8); PG8_WAIT_L(0); PG8_BAR; PG8_MMA(1, 0, At, B0); PG8_MMA(1, 1, At, B1); PG8_BAR; PG8_SCHED;
            PG8_LDB(B0, 1, 0); PG8_LDB(B1, 1, 1); PG8_SCHED; PG8_LDA(At, 1, 0); PG8_STAGE(PG8_SA(0, 1), a2 + hstep, voffA);
            PG8_WAIT_V(8); PG8_WAIT_L(0); PG8_BAR; PG8_MMA(0, 0, At, B0); PG8_MMA(0, 1, At, B1); PG8_BAR; PG8_SCHED;
            PG8_LDA(At, 1, 1); PG8_STAGE(PG8_SB(1, 0), b3, voffB); PG8_STAGE(PG8_SB(1, 1), b3 + hstep, voffB); PG8_STAGE(PG8_SA(1, 0), a3, voffA);
            PG8_WAIT_V(8); PG8_WAIT_L(0); PG8_BAR; PG8_MMA(1, 0, At, B0); PG8_MMA(1, 1, At, B1); PG8_BAR; PG8_SCHED;
            } else {
            PG8_LDB(B0, 0, 0); PG8_SCHED; PG8_LDA(At, 0, 0); PG8_STAGE(PG8_SA(1, 1), a1 + hstep, voffA);
            PG8_WAIT_L(8); PG8_BAR; PG8_WAIT_L(0); PG8_MMA(0, 0, At, B0); PG8_BAR; PG8_SCHED;
            PG8_LDB(B1, 0, 1); PG8_STAGE(PG8_SB(0, 0), b2, voffB);
            PG8_BAR; PG8_WAIT_L(0); PG8_MMA(0, 1, At, B1); PG8_BAR;
            PG8_LDA(At, 0, 1); PG8_STAGE(PG8_SA(0, 0), a2, voffA);
            PG8_BAR; PG8_WAIT_L(0); PG8_MMA(1, 0, At, B0); PG8_BAR; PG8_SCHED;
            PG8_STAGE(PG8_SB(0, 1), b2 + hstep, voffB);
            PG8_WAIT_V(6); PG8_BAR; PG8_MMA(1, 1, At, B1); PG8_BAR;
            PG8_LDB(B0, 1, 0); PG8_SCHED; PG8_LDA(At, 1, 0); PG8_STAGE(PG8_SA(0, 1), a2 + hstep, voffA);
            PG8_WAIT_L(8); PG8_BAR; PG8_WAIT_L(0); PG8_MMA(0, 0, At, B0); PG8_BAR; PG8_SCHED;
            PG8_LDB(B1, 1, 1); PG8_STAGE(PG8_SB(1, 0), b3, voffB);
            PG8_BAR; PG8_WAIT_L(0); PG8_MMA(0, 1, At, B1); PG8_BAR;
            PG8_LDA(At, 1, 1); PG8_STAGE(PG8_SA(1, 0), a3, voffA);
            PG8_BAR; PG8_WAIT_L(0); PG8_MMA(1, 0, At, B0); PG8_BAR; PG8_SCHED;
            PG8_STAGE(PG8_SB(1, 1), b3 + hstep, voffB);
            PG8_WAIT_V(6); PG8_BAR; PG8_MMA(1, 1, At, B1); PG8_BAR;
            }
        }
        if constexpr (ALIGN_EPI) { if (wr == 0) PG8_BAR; }
        if constexpr (!Epi::AFTER_DRAIN) { E(acc, cur, wr, wc, fr, fq); S.done(cur); }
        if (!has_next) break;
#pragma unroll
        for (int a = 0; a < 2; ++a)
#pragma unroll
            for (int b = 0; b < 2; ++b)
#pragma unroll
                for (int m = 0; m < 4; ++m)
#pragma unroll
                    for (int n = 0; n < 2; ++n) acc[a][b][m][n] = (f32x4){0.f, 0.f, 0.f, 0.f};
        cur = nxt; cA = nA; cB = nB; ++ui;
        if constexpr (ALIGN_EPI) { if (wr == 1) PG8_BAR; }
    }
    PG8_WAIT_V(0);
    if constexpr (!ALIGN_EPI) { if (wr == 0) PG8_BAR; }
    PG8_BAR;
    if constexpr (Epi::AFTER_DRAIN) { E.fused(acc, cur, wr, wc, fr, fq, lds, wid, lane); S.done(cur); }
#undef PG8_SA
#undef PG8_SB
#undef PG8_STAGE
#undef PG8_LDA
#undef PG8_LDB
#undef PG8_MMA
#undef PG8_WAIT_V
#undef PG8_WAIT_L
#undef PG8_BAR
#undef PG8_SCHED
}
}
#define GAS __attribute__((address_space(1)))
#define LAS __attribute__((address_space(3)))
typedef unsigned short bf16;
typedef unsigned u32x4 __attribute__((ext_vector_type(4)));
typedef unsigned u32x2 __attribute__((ext_vector_type(2)));
typedef float f32x4 __attribute__((ext_vector_type(4)));
typedef float f32x2 __attribute__((ext_vector_type(2)));
typedef float f32x16 __attribute__((ext_vector_type(16)));
typedef short bf16x8 __attribute__((ext_vector_type(8)));
typedef short s16x4 __attribute__((ext_vector_type(4)));
typedef short v4i16_t __attribute__((ext_vector_type(4)));

constexpr int D = 1024, NLAT = 16384, NCTXR = 2048, NROWS = 18432;
constexpr size_t MiB = 1u << 20;
constexpr size_t WS_CTL = 0, CTL_ZERO_BYTES = 128 * 1024;
constexpr size_t WS_MODV = 1 * MiB;
constexpr size_t WS_TAB = 2 * MiB;
constexpr size_t WS_WQKV = 3 * MiB, WS_WO = 12 * MiB, WS_WGLU = 16 * MiB, WS_WGU = 24 * MiB, WS_WD = 152 * MiB, WS_SSM = 216 * MiB;
constexpr size_t WS_H = 264 * MiB, WS_XN = 336 * MiB, WS_ARENA = 372 * MiB, WS_END = 570 * MiB;
constexpr size_t WS_Q = WS_ARENA, WS_K = WS_Q + (size_t)NROWS * 1024 * 2, WS_V = WS_K + (size_t)NROWS * 640 * 2, WS_O12 = WS_ARENA + 81 * MiB, WS_MERGED = WS_ARENA + 153 * MiB;
constexpr int MAXSLOT = 45056;
constexpr size_t WS_XS = WS_ARENA, WS_HID = WS_ARENA + 88 * MiB, WS_YS = WS_ARENA + 110 * MiB;
static_assert(WS_V + (size_t)NROWS * 640 * 2 <= WS_O12 && WS_O12 + (size_t)NROWS * 1024 * 4 <= WS_MERGED && WS_MERGED + (size_t)NROWS * 1024 * 2 <= WS_END, "mixer arena");
static_assert((size_t)MAXSLOT * 2048 <= 88 * MiB && (size_t)MAXSLOT * 512 <= 22 * MiB && WS_YS + (size_t)MAXSLOT * 2048 <= WS_END, "moe arena");
constexpr size_t TAB_ROUTE_I = 64 * 1024, TAB_ROUTE_W = 384 * 1024, TAB_ROUTE_S = 576 * 1024, TAB_WSLOT = 768 * 1024;
constexpr int CW_BAR = 1024;
constexpr int CW_CNT = 8192;
constexpr int CW_TILE = 8192 + 4 * 32 * 64;
static_assert((CW_TILE + 4 * 256) * 4 <= (int)CTL_ZERO_BYTES, "ctl");
constexpr int PH_LDS = 155648, LDS_BARW = PH_LDS, LDS_BYTES = PH_LDS + 256;

#ifndef MK_F16
#define MK_F16 1
#endif
typedef _Float16 h16x8 __attribute__((ext_vector_type(8)));
typedef _Float16 h16x2 __attribute__((ext_vector_type(2)));
#if MK_F16
__device__ __forceinline__ float clamp16(float f) { return fminf(fmaxf(f, -65504.f), 65504.f); }
__device__ __forceinline__ unsigned f2bf(float f) { return (unsigned)__builtin_bit_cast(unsigned short, (_Float16)f); }
__device__ __forceinline__ unsigned pk2(float lo, float hi) { const h16x2 v = {(_Float16)lo, (_Float16)hi}; return __builtin_bit_cast(unsigned, v); }
__device__ __forceinline__ float bf2f(unsigned short h) { return (float)__builtin_bit_cast(_Float16, h); }
__device__ __forceinline__ float bflo(unsigned w) { return (float)__builtin_bit_cast(h16x2, w)[0]; }
__device__ __forceinline__ float bfhi(unsigned w) { return (float)__builtin_bit_cast(h16x2, w)[1]; }
#define MFMA16(a, b, c) __builtin_amdgcn_mfma_f32_16x16x32_f16(__builtin_bit_cast(h16x8, a), __builtin_bit_cast(h16x8, b), c, 0, 0, 0)
#define MFMA32(a, b, c) __builtin_amdgcn_mfma_f32_32x32x16_f16(__builtin_bit_cast(h16x8, a), __builtin_bit_cast(h16x8, b), c, 0, 0, 0)
#else
__device__ __forceinline__ float clamp16(float f) { return f; }
__device__ __forceinline__ unsigned f2bf(float f) { unsigned u = __builtin_bit_cast(unsigned, f); return (u + 0x7fffu + ((u >> 16) & 1u)) >> 16; }
__device__ __forceinline__ unsigned pk2(float lo, float hi) { return f2bf(lo) | (f2bf(hi) << 16); }
__device__ __forceinline__ float bf2f(unsigned short h) { return __builtin_bit_cast(float, (unsigned)h << 16); }
__device__ __forceinline__ float bflo(unsigned w) { return __builtin_bit_cast(float, w << 16); }
__device__ __forceinline__ float bfhi(unsigned w) { return __builtin_bit_cast(float, w & 0xffff0000u); }
#define MFMA16(a, b, c) __builtin_amdgcn_mfma_f32_16x16x32_bf16(a, b, c, 0, 0, 0)
#define MFMA32(a, b, c) __builtin_amdgcn_mfma_f32_32x32x16_bf16(a, b, c, 0, 0, 0)
#endif
template <int M> __device__ __forceinline__ float swz_xor(float v) { return __builtin_bit_cast(float, __builtin_amdgcn_ds_swizzle(__builtin_bit_cast(int, v), (M << 10) | 0x1f)); }
__device__ __forceinline__ void xor32_pair(float v, float& r0, float& r1) { float a = v, b = v;
    asm volatile("s_nop 1\n\tv_permlane32_swap_b32 %0, %1" : "+v"(a), "+v"(b));
    r0 = a; r1 = b; }
__device__ __forceinline__ float xor32_sum(float v) { float a, b; xor32_pair(v, a, b); return a + b; }
__device__ __forceinline__ float xor32_max(float v) { float a, b; xor32_pair(v, a, b); return fmaxf(a, b); }
__device__ __forceinline__ float wave_sum(float v) {
    v += swz_xor<1>(v); v += swz_xor<2>(v); v += swz_xor<4>(v); v += swz_xor<8>(v); v += swz_xor<16>(v);
    const int vi = __builtin_bit_cast(int, v);
    return __builtin_bit_cast(float, __builtin_amdgcn_readlane(vi, 0)) + __builtin_bit_cast(float, __builtin_amdgcn_readlane(vi, 32));
}
__device__ __forceinline__ unsigned ld_agent(const unsigned* p) { return __hip_atomic_load(p, __ATOMIC_RELAXED, __HIP_MEMORY_SCOPE_AGENT); }
__device__ __forceinline__ int mrow_of(int row) { return row < NLAT ? (row >> 11) : 8; }
__device__ __forceinline__ float gelu_tanh_f(float x) {
    const float u = 0.7978845608028654f * (x + 0.044715f * x * x * x);
    return x / (1.f + __expf(-2.f * u));
}
__device__ __forceinline__ float sigmoid_f(float x) { return 1.f / (1.f + __expf(-x)); }

#define XB_TMO      128
#define XB_XCNT(j)  (256  + 64 * (j))
#define XB_XSUB(j)  (1280 + 64 * (j))
#define XB_XGEN(j)  (2304 + 64 * (j))
#define XB_TOP      3328
#define XB_TOPGEN   3392
#define XCD_BAR_WORDS 3456
#define XB_SPIN_CAP (1u << 18)
__device__ __forceinline__ unsigned xb_ld(unsigned* p)              { return __hip_atomic_load(p, __ATOMIC_RELAXED, __HIP_MEMORY_SCOPE_AGENT); }
__device__ __forceinline__ unsigned xb_add(unsigned* p, unsigned v) { return __hip_atomic_fetch_add(p, v, __ATOMIC_RELAXED, __HIP_MEMORY_SCOPE_AGENT); }
__device__ __forceinline__ unsigned xb_xcc_id() { return (unsigned)__builtin_amdgcn_s_getreg((3 << 11) | 20) & 0xFu; }
#define XB_SPIN(cond, bar) do { unsigned _sp = 0; while (cond) { __builtin_amdgcn_s_sleep(1); \
    if ((++_sp & 255u) == 0u) { if (xb_ld(&(bar)[XB_TMO])) break; if (_sp > XB_SPIN_CAP) { atomicAdd(&(bar)[XB_TMO], 1u); break; } } } } while (0)
struct XcdBarrier { unsigned* bar; unsigned x; volatile LAS unsigned* st; };
__device__ __forceinline__ XcdBarrier xcd_barrier_post(unsigned* bar, volatile LAS unsigned* st) {
    XcdBarrier b; b.bar = bar; b.x = xb_xcc_id(); b.st = st;
    if (threadIdx.x == 0) (void)xb_add(&bar[XB_XCNT(b.x)], 1u);
    return b;
}
__device__ __forceinline__ void xcd_barrier_complete(unsigned* bar, unsigned x, unsigned& nloc, unsigned& nx) {
    const unsigned G = gridDim.x * gridDim.y * gridDim.z;
    unsigned sum, cnt, mine, sp = 0u;
    for (;;) {
        sum = 0u; cnt = 0u; mine = 0u;
#pragma unroll
        for (unsigned j = 0; j < 16; ++j) { const unsigned c = xb_ld(&bar[XB_XCNT(j)]); sum += c; cnt += (c > 0u) ? 1u : 0u; mine = (j == x) ? c : mine; }
        if (sum == G) break;
        __builtin_amdgcn_s_sleep(1);
        if ((++sp & 255u) == 0u) { if (xb_ld(&bar[XB_TMO])) break; if (sp > XB_SPIN_CAP) { atomicAdd(&bar[XB_TMO], 1u); break; } }
    }
    nloc = mine > 0u ? mine : 1u; nx = cnt > 0u ? cnt : 1u;
}
template <bool FIRST> __device__ __forceinline__ void xcd_barrier(const XcdBarrier& b) {
    asm volatile("s_waitcnt vmcnt(0)" ::: "memory");
    __syncthreads();
    if (threadIdx.x == 0) {
        unsigned* bar = b.bar;
        __builtin_amdgcn_s_waitcnt(0);
        unsigned nloc = b.st[0], nx = b.st[1];
        if (FIRST) { if (nloc == 0u) { xcd_barrier_complete(bar, b.x, nloc, nx); b.st[0] = nloc; b.st[1] = nx; } }
        const unsigned old = xb_add(&bar[XB_XSUB(b.x)], 1u);
        const unsigned gen = old / nloc;
        if (old + 1u == (gen + 1u) * nloc) {
            __builtin_amdgcn_fence(__ATOMIC_RELEASE, "agent");
            asm volatile("s_waitcnt vmcnt(0)" ::: "memory");
            const unsigned og = xb_add(&bar[XB_TOP], 1u);
            const unsigned tg = og / nx;
            if (og + 1u == (tg + 1u) * nx) xb_add(&bar[XB_TOPGEN], 1u);
            else XB_SPIN(xb_ld(&bar[XB_TOPGEN]) == tg, bar);
            __builtin_amdgcn_fence(__ATOMIC_ACQUIRE, "agent");
            xb_add(&bar[XB_XGEN(b.x)], 1u);
            asm volatile("s_waitcnt vmcnt(0)" ::: "memory");
        } else {
            XB_SPIN(xb_ld(&bar[XB_XGEN(b.x)]) == gen, bar);
            __builtin_amdgcn_fence(__ATOMIC_ACQUIRE, "agent");
            asm volatile("s_waitcnt vmcnt(0)" ::: "memory");
        }
    }
    __syncthreads();
}

using pg8::Unit; using pg8::HALF; using pg8::BM;

struct EpiQKV {
    static constexpr bool PERM = true, AFTER_DRAIN = false;
    bf16* Q; bf16* K; bf16* V; const float* qg; const float* kg; const float* rope;
    __device__ __forceinline__ void operator()(const f32x4 (&acc)[2][2][4][2], const Unit& u, int wr, int wc, int fr, int fq) const {
        const int hs = u.pn * 4 + wc;
        const bool is_q = hs < 8 || (hs >= 12 && hs < 20), is_k = (hs >= 8 && hs < 10) || (hs >= 20 && hs < 28);
        const bool do_norm = hs < 10, do_rope = (is_q || is_k) && (u.pm < 64);
        bf16* dst; int pitch;
        if (is_q) { dst = Q + (hs < 8 ? hs : hs - 4) * 64; pitch = 1024; }
        else if (is_k) { dst = K + (hs < 10 ? hs - 8 : hs - 18) * 64; pitch = 640; }
        else { dst = V + (hs < 12 ? hs - 10 : hs - 26) * 64; pitch = 640; }
        const float qscale = is_q ? 0.125f * 1.4426950408889634f : 1.0f;
        f32x4 gv[2][2];
#pragma unroll
        for (int bj = 0; bj < 2; ++bj)
#pragma unroll
            for (int n = 0; n < 2; ++n) gv[bj][n] = do_norm ? *(const f32x4*)((hs < 8 ? qg : kg) + 32 * bj + 16 * n + 4 * fq) : (f32x4){1.f, 1.f, 1.f, 1.f};
#pragma unroll
        for (int ai = 0; ai < 2; ++ai)
#pragma unroll
            for (int m = 0; m < 4; ++m) {
                const int row = u.pm * BM + ai * HALF + wr * 64 + m * 16 + fr;
                f32x4 v[2][2];
#pragma unroll
                for (int bj = 0; bj < 2; ++bj)
#pragma unroll
                    for (int n = 0; n < 2; ++n) v[bj][n] = acc[ai][bj][m][n];
                if (do_norm) {
                    float ss = 0.f;
#pragma unroll
                    for (int bj = 0; bj < 2; ++bj)
#pragma unroll
                        for (int n = 0; n < 2; ++n) ss += (v[bj][n][0] * v[bj][n][0] + v[bj][n][1] * v[bj][n][1]) + (v[bj][n][2] * v[bj][n][2] + v[bj][n][3] * v[bj][n][3]);
                    ss += swz_xor<16>(ss); ss = xor32_sum(ss);
                    const float r = rsqrtf(ss * (1.f / 64.f) + 1e-6f);
#pragma unroll
                    for (int bj = 0; bj < 2; ++bj)
#pragma unroll
                        for (int n = 0; n < 2; ++n) v[bj][n] = v[bj][n] * r * gv[bj][n];
                }
                if (do_rope) {
                    const int t = row & 2047;
#pragma unroll
                    for (int bj = 0; bj < 2; ++bj) {
                        const int pos = bj == 0 ? (t >> 6) : (t & 63);
                        const float* tp = rope + (pos * 16 + 4 * fq) * 2;
                        const f32x4 t0 = *(const f32x4*)tp, t1 = *(const f32x4*)(tp + 4);
                        const f32x4 cs = {t0[0], t0[2], t1[0], t1[2]}, sn = {t0[1], t0[3], t1[1], t1[3]};
                        const f32x4 x0 = v[bj][0], x1 = v[bj][1];
                        v[bj][0] = x0 * cs - x1 * sn; v[bj][1] = x1 * cs + x0 * sn;
                    }
                }
                bf16* rp = dst + (size_t)row * pitch;
#pragma unroll
                for (int bj = 0; bj < 2; ++bj)
#pragma unroll
                    for (int n = 0; n < 2; ++n) { const f32x4 o = v[bj][n] * qscale; u32x2 w; w.x = pk2(o[0], o[1]); w.y = pk2(o[2], o[3]);
                        *(u32x2*)(rp + 32 * bj + 16 * n + 4 * fq) = w; }
            }
    }
};
struct EpiResid {
    static constexpr bool PERM = false, AFTER_DRAIN = false;
    float* h; const float* gate;
    __device__ __forceinline__ void operator()(const f32x4 (&acc)[2][2][4][2], const Unit& u, int wr, int wc, int fr, int fq) const {
        const int mr = u.pm < 64 ? (u.pm >> 3) : 8; const float* gp = gate + mr * 6144;
        const int row0 = u.pm * BM + wr * 64 + fr, col0 = u.pn * BM + wc * 32 + 4 * fq;
#pragma unroll
        for (int bj = 0; bj < 2; ++bj)
#pragma unroll
            for (int n = 0; n < 2; ++n) { const int col = col0 + bj * HALF + 16 * n; const f32x4 gv = *(const f32x4*)(gp + col);
#pragma unroll
                for (int ai = 0; ai < 2; ++ai)
#pragma unroll
                    for (int m = 0; m < 4; ++m) { float* p = h + (size_t)(row0 + ai * HALF + m * 16) * D + col; *(f32x4*)p = *(const f32x4*)p + gv * acc[ai][bj][m][n]; } }
    }
};
struct EpiGLU {
    static constexpr bool PERM = true, AFTER_DRAIN = false;
    float* h; const float* gate;
    __device__ __forceinline__ void operator()(const f32x4 (&acc)[2][2][4][2], const Unit& u, int wr, int wc, int fr, int fq) const {
        const int mr = u.pm < 64 ? (u.pm >> 3) : 8; const float* gp = gate + mr * 6144;
        const int row0 = u.pm * BM + wr * 64 + fr, col0 = u.pn * 128 + wc * 16 + 4 * fq;
#pragma unroll
        for (int bj = 0; bj < 2; ++bj) { const int col = col0 + bj * 64; const f32x4 gv = *(const f32x4*)(gp + col);
#pragma unroll
            for (int ai = 0; ai < 2; ++ai)
#pragma unroll
                for (int m = 0; m < 4; ++m) { float* p = h + (size_t)(row0 + ai * HALF + m * 16) * D + col; const f32x4 a = acc[ai][bj][m][0], b = acc[ai][bj][m][1];
                    f32x4 y; y[0] = a[0] * sigmoid_f(b[0]); y[1] = a[1] * sigmoid_f(b[1]); y[2] = a[2] * sigmoid_f(b[2]); y[3] = a[3] * sigmoid_f(b[3]);
                    *(f32x4*)p = *(const f32x4*)p + gv * y; } }
    }
};
struct EpiGateUp {
    static constexpr bool PERM = true, AFTER_DRAIN = false;
    bf16* hid; const float* wslot;
    __device__ __forceinline__ void operator()(const f32x4 (&acc)[2][2][4][2], const Unit& u, int wr, int wc, int fr, int fq) const {
        const int row0 = u.pm * BM + wr * 64 + fr, col0 = (u.pn & 1) * 128 + wc * 16 + 4 * fq;
#pragma unroll
        for (int ai = 0; ai < 2; ++ai)
#pragma unroll
            for (int m = 0; m < 4; ++m) { const int row = row0 + ai * HALF + m * 16; const float w = wslot[row];
#pragma unroll
                for (int bj = 0; bj < 2; ++bj) { const f32x4 g = acc[ai][bj][m][0], up = acc[ai][bj][m][1]; f32x4 y;
                    y[0] = g[0] * sigmoid_f(g[0]) * up[0] * w; y[1] = g[1] * sigmoid_f(g[1]) * up[1] * w; y[2] = g[2] * sigmoid_f(g[2]) * up[2] * w; y[3] = g[3] * sigmoid_f(g[3]) * up[3] * w;
                    u32x2 o; o.x = pk2(clamp16(y[0]), clamp16(y[1])); o.y = pk2(clamp16(y[2]), clamp16(y[3]));
                    *(u32x2*)(hid + (size_t)row * 256 + col0 + bj * 64) = o; } }
    }
};
struct EpiDown {
    static constexpr bool PERM = true, AFTER_DRAIN = false;
    bf16* ys;
    __device__ __forceinline__ void operator()(const f32x4 (&acc)[2][2][4][2], const Unit& u, int wr, int wc, int fr, int fq) const {
        const int row0 = u.pm * BM + wr * 64 + fr, col0 = (u.pn & 3) * 256 + wc * 32 + 8 * fq;
#pragma unroll
        for (int ai = 0; ai < 2; ++ai)
#pragma unroll
            for (int m = 0; m < 4; ++m) { bf16* rp = ys + (size_t)(row0 + ai * HALF + m * 16) * D + col0;
#pragma unroll
                for (int bj = 0; bj < 2; ++bj) { const f32x4 v0 = acc[ai][bj][m][0], v1 = acc[ai][bj][m][1]; u32x4 w; w.x = pk2(clamp16(v0[0]), clamp16(v0[1])); w.y = pk2(clamp16(v0[2]), clamp16(v0[3])); w.z = pk2(clamp16(v1[0]), clamp16(v1[1])); w.w = pk2(clamp16(v1[2]), clamp16(v1[3]));
                    *(u32x4*)(rp + bj * HALF) = w; } }
    }
};
struct MoeOrder {
    const unsigned* tbl; int nsub, G, c;
    __device__ __forceinline__ bool next(int i, Unit& u) const {
        const int L = i * G + c; const int T = (int)__builtin_amdgcn_readfirstlane(ld_agent(tbl));
        if (L >= T * nsub) return false;
        const int t = L / nsub, s = L - t * nsub; const int e = (int)__builtin_amdgcn_readfirstlane(ld_agent(tbl + 1 + t));
        u.pm = t; u.pn = e * nsub + s; return true;
    }
    __device__ __forceinline__ void a_ready(const Unit&) const {}
    __device__ __forceinline__ void done(const Unit&) const {}
};
constexpr int AT_KOFF0 = 0, AT_VOFF0 = 8192, AT_BUF = 24576, AT_SCR = 49152;
__device__ __forceinline__ int crow(int r, int hi) { return (r & 3) + 8 * (r >> 2) + 4 * hi; }
__device__ __forceinline__ int v_off(int kv, int col) { return (col >> 5) * 4096 + (kv >> 3) * 512 + (kv & 7) * 64 + (col & 31) * 2; }
__device__ __forceinline__ s16x4 vtr(const LAS unsigned char* p) { return __builtin_bit_cast(s16x4, __builtin_amdgcn_ds_read_tr16_b64_v4i16((LAS v4i16_t*)p)); }

template <int VD>
__device__ __forceinline__ void attn_unit(LAS unsigned char* lds, const bf16* Qb, const bf16* Kb, const bf16* Vb, bf16* merged, float* o12,
                                          int b, int qrow0, bool lat, int qcol, int kcol, int vcol, int ocol) {
    int tid_ = threadIdx.x; asm volatile("" : "+v"(tid_));
    const int tid = tid_, lane = tid & 63, r32 = lane & 31, hi = lane >> 5; const int wid = __builtin_amdgcn_readfirstlane(tid >> 6);
    constexpr int NDB = VD / 32, NVP = VD / 64;
    const int NT = lat ? 36 : 4;
    const int k_kv = tid >> 3, k_c = tid & 7;
    const int k_dst = k_kv * 128 + ((k_c ^ ((k_kv >> 1) & 7)) << 4);
    int v_kv[NVP], v_c8[NVP], v_dst[NVP];
#pragma unroll
    for (int i = 0; i < NVP; ++i) { const int id = tid + 512 * i; v_kv[i] = VD == 64 ? (id >> 3) : (id >> 4); v_c8[i] = VD == 64 ? (id & 7) : (id & 15); v_dst[i] = v_off(v_kv[i], v_c8[i] * 8); }
    auto tile_row0 = [&](int t) -> int { return lat ? (t < 4 ? NLAT + b * 256 + t * 64 : b * 2048 + (t - 4) * 64) : NLAT + b * 256 + t * 64; };
    bf16x8 qf[4];
    { const bf16* qp = Qb + (size_t)(qrow0 + wid * 32 + r32) * 1024 + qcol + hi * 8;
#pragma unroll
      for (int d0 = 0; d0 < 4; ++d0) qf[d0] = *(const bf16x8*)(qp + d0 * 16); }
    f32x16 o[NDB];
#pragma unroll
    for (int i = 0; i < NDB; ++i) o[i] = (f32x16){};
    float m_run = -1e30f, l_run = 0.f;
    LAS float* scr = (LAS float*)(lds + AT_SCR) + wid * 32;
    u32x4 kreg, vreg[NVP];
    { const int r0 = tile_row0(0);
      kreg = *(const u32x4*)(Kb + (size_t)(r0 + k_kv) * 640 + kcol + k_c * 8);
#pragma unroll
      for (int i = 0; i < NVP; ++i) vreg[i] = *(const u32x4*)(Vb + (size_t)(r0 + v_kv[i]) * 640 + vcol + v_c8[i] * 8);
      *(LAS u32x4*)(lds + AT_KOFF0 + k_dst) = kreg;
#pragma unroll
      for (int i = 0; i < NVP; ++i) *(LAS u32x4*)(lds + AT_VOFF0 + v_dst[i]) = vreg[i]; }
    __syncthreads();
    const int ka_off = r32 * 128, ksw = (r32 >> 1) & 7;
    const int vt_off = ((lane >> 4) & 1) * 32 + (lane & 3) * 8 + (4 * hi + ((lane & 15) >> 2)) * 64;
    for (int t = 0; t < NT; ++t) {
        const int cur = (t & 1) * AT_BUF;
        if (t + 1 < NT) { const int r0 = tile_row0(t + 1);
            kreg = *(const u32x4*)(Kb + (size_t)(r0 + k_kv) * 640 + kcol + k_c * 8);
#pragma unroll
            for (int i = 0; i < NVP; ++i) vreg[i] = *(const u32x4*)(Vb + (size_t)(r0 + v_kv[i]) * 640 + vcol + v_c8[i] * 8); }
        f32x16 p0 = (f32x16){}, p1 = (f32x16){};
        const LAS unsigned char* kb = lds + cur + AT_KOFF0 + ka_off;
#pragma unroll
        for (int d0 = 0; d0 < 4; ++d0) { const int ch = ((2 * d0 + hi) ^ ksw) << 4;
            const bf16x8 a0 = *(const LAS bf16x8*)(kb + ch), a1 = *(const LAS bf16x8*)(kb + 4096 + ch);
            p0 = MFMA32(a0, qf[d0], p0);
            p1 = MFMA32(a1, qf[d0], p1); }
        float mx = fmaxf(p0[0], p1[0]);
#pragma unroll
        for (int r = 1; r < 16; ++r) mx = fmaxf(mx, fmaxf(p0[r], p1[r]));
        mx = xor32_max(mx);
        const float m_new = fmaxf(m_run, mx);
        if (__any(m_new > m_run)) {
            const float alpha = __builtin_amdgcn_exp2f(m_run - m_new);
            l_run *= alpha; m_run = m_new;
            if (hi == 0) scr[r32] = alpha;
            f32x4 a4[4];
#pragma unroll
            for (int i = 0; i < 4; ++i) a4[i] = *(const LAS f32x4*)(scr + 8 * i + 4 * hi);
#pragma unroll
            for (int db = 0; db < NDB; ++db)
#pragma unroll
                for (int r = 0; r < 16; ++r) o[db][r] *= a4[r >> 2][r & 3];
        }
        float ls = 0.f;
#pragma unroll
        for (int r = 0; r < 16; ++r) { p0[r] = __builtin_amdgcn_exp2f(p0[r] - m_run); p1[r] = __builtin_amdgcn_exp2f(p1[r] - m_run); ls += p0[r] + p1[r]; }
        l_run += ls;
        u32x4 pw[4];
#pragma unroll
        for (int i = 0; i < 4; ++i) { pw[0][i] = pk2(p0[2 * i], p0[2 * i + 1]); pw[1][i] = pk2(p0[8 + 2 * i], p0[9 + 2 * i]); pw[2][i] = pk2(p1[2 * i], p1[2 * i + 1]); pw[3][i] = pk2(p1[8 + 2 * i], p1[9 + 2 * i]); }
        const LAS unsigned char* vb = lds + cur + AT_VOFF0 + vt_off;
#pragma unroll
        for (int db = 0; db < NDB; ++db)
#pragma unroll
            for (int ks = 0; ks < 4; ++ks) { const s16x4 lo = vtr(vb + db * 4096 + ks * 1024), hh = vtr(vb + db * 4096 + ks * 1024 + 512);
                const bf16x8 vf = {lo[0], lo[1], lo[2], lo[3], hh[0], hh[1], hh[2], hh[3]};
                o[db] = MFMA32(__builtin_bit_cast(bf16x8, pw[ks]), vf, o[db]); }
        if (t + 1 < NT) { const int nxt = ((t + 1) & 1) * AT_BUF;
            *(LAS u32x4*)(lds + nxt + AT_KOFF0 + k_dst) = kreg;
#pragma unroll
            for (int i = 0; i < NVP; ++i) *(LAS u32x4*)(lds + nxt + AT_VOFF0 + v_dst[i]) = vreg[i]; }
        __syncthreads();
    }
    l_run = xor32_sum(l_run);
    if (hi == 0) scr[r32] = 1.f / l_run;
    f32x4 a4[4];
#pragma unroll
    for (int i = 0; i < 4; ++i) a4[i] = *(const LAS f32x4*)(scr + 8 * i + 4 * hi);
#pragma unroll
    for (int r = 0; r < 16; ++r) { const int row = qrow0 + wid * 32 + crow(r, hi); const float li = a4[r >> 2][r & 3];
#pragma unroll
        for (int db = 0; db < NDB; ++db) {
            if (VD == 64) merged[(size_t)row * D + ocol + db * 32 + r32] = (bf16)f2bf(o[db][r] * li);
            else o12[(size_t)row * D + ocol + db * 32 + r32] = o[db][r] * li; } }
    __syncthreads();
}

constexpr int SS_AST = 1040;
__device__ __forceinline__ int ssm_row(int b, int j, int t) { return j < 16 ? NLAT + b * 256 + 16 * j + t : b * 2048 + 16 * (j - 16) + t; }
__device__ __forceinline__ void ssm_unit(LAS unsigned char* lds, int b, int g, const bf16* xn, bf16* gout, const bf16* W1t, const bf16* W2t,
                                         const float* are, const float* aim, const float* logdt, const float* dskip) {
    int tid_ = threadIdx.x; asm volatile("" : "+v"(tid_));
    const int tid = tid_, lane = tid & 63, fr = lane & 15, fq = lane >> 4; const int w = __builtin_amdgcn_readfirstlane(tid >> 6);
    for (int id = tid; id < 144 * 32; id += 512) { const int j = id >> 5, rem = id & 31, t = rem >> 1, hf = rem & 1;
        const u32x4 v = *(const u32x4*)(xn + (size_t)ssm_row(b, j, t) * D + 16 * g + 8 * hf);
        *(LAS u32x4*)(lds + j * SS_AST + (t * 16 + 8 * hf) * 2) = v; }
    __syncthreads();
    f32x4 acc[9][2];
    bf16x8 bfr[2][8];
#pragma unroll
    for (int rt = 0; rt < 9; ++rt) { acc[rt][0] = (f32x4){0.f, 0.f, 0.f, 0.f}; acc[rt][1] = (f32x4){0.f, 0.f, 0.f, 0.f}; }
#pragma unroll
    for (int ct = 0; ct < 2; ++ct)
#pragma unroll
        for (int ks = 0; ks < 8; ++ks) bfr[ct][ks] = *(const bf16x8*)(W1t + (size_t)(32 * w + 16 * ct + fr) * 256 + 32 * ks + 8 * fq);
#pragma unroll
    for (int rt = 0; rt < 9; ++rt)
#pragma unroll
        for (int ks = 0; ks < 8; ++ks) { const bf16x8 a = *(const LAS bf16x8*)(lds + (16 * rt + fr) * SS_AST + (32 * ks + 8 * fq) * 2);
            acc[rt][0] = MFMA16(a, bfr[0][ks], acc[rt][0]);
            acc[rt][1] = MFMA16(a, bfr[1][ks], acc[rt][1]); }
#pragma unroll
    for (int rt = 0; rt < 9; ++rt)
#pragma unroll
        for (int ct = 0; ct < 2; ++ct)
#pragma unroll
            for (int r = 0; r < 4; ++r) *(LAS bf16*)(lds + (16 * rt + 4 * fq + r) * SS_AST + (256 + 32 * w + 16 * ct + fr) * 2) = (bf16)f2bf(clamp16(acc[rt][ct][r]));
    __syncthreads();
    if (tid < 128) {
        const int dir = tid >> 6, p = tid & 63; const int gp = (dir * 64 + g) * 64 + p;
        const float lre = fminf(are[gp], -1e-4f), lim = aim[gp], dt = expf(logdt[dir * 64 + g]);
        const float mag = expf(16.f * lre * dt), ang = 16.f * lim * dt; const float l16r = mag * cosf(ang), l16i = mag * sinf(ang);
        LAS bf16* colre = (LAS bf16*)(lds + (256 + dir * 128 + p) * 2); LAS bf16* colim = colre + 64;
        float Hr = 0.f, Hi = 0.f;
        for (int step = 0; step < 144; ++step) {
            const int j = dir == 0 ? step : (step < 16 ? 15 - step : 159 - step);
            LAS bf16* pr = (LAS bf16*)((LAS unsigned char*)colre + j * SS_AST); LAS bf16* pi = (LAS bf16*)((LAS unsigned char*)colim + j * SS_AST);
            const float sr = bf2f(*pr), si = bf2f(*pi);
            *pr = (bf16)f2bf(clamp16(Hr)); *pi = (bf16)f2bf(clamp16(Hi));
            const float nr = l16r * Hr - l16i * Hi + sr, ni = l16r * Hi + l16i * Hr + si; Hr = nr; Hi = ni;
        }
    }
    __syncthreads();
#pragma unroll
    for (int rt = 0; rt < 9; ++rt) { acc[rt][0] = (f32x4){0.f, 0.f, 0.f, 0.f}; acc[rt][1] = (f32x4){0.f, 0.f, 0.f, 0.f}; }
#pragma unroll
    for (int kh = 0; kh < 2; ++kh) {
#pragma unroll
        for (int ct = 0; ct < 2; ++ct)
#pragma unroll
            for (int ks = 0; ks < 8; ++ks) bfr[ct][ks] = *(const bf16x8*)(W2t + (size_t)(32 * w + 16 * ct + fr) * 512 + 256 * kh + 32 * ks + 8 * fq);
#pragma unroll
        for (int rt = 0; rt < 9; ++rt)
#pragma unroll
            for (int ks = 0; ks < 8; ++ks) { const bf16x8 a = *(const LAS bf16x8*)(lds + (16 * rt + fr) * SS_AST + (256 * kh + 32 * ks + 8 * fq) * 2);
                acc[rt][0] = MFMA16(a, bfr[0][ks], acc[rt][0]);
                acc[rt][1] = MFMA16(a, bfr[1][ks], acc[rt][1]); }
    }
    const float dsk = dskip[16 * g + fr];
#pragma unroll
    for (int rt = 0; rt < 9; ++rt)
#pragma unroll
        for (int ct = 0; ct < 2; ++ct) { const int t = 2 * w + ct;
#pragma unroll
            for (int r = 0; r < 4; ++r) { const int j = 16 * rt + 4 * fq + r;
                const float u = bf2f(*(const LAS bf16*)(lds + j * SS_AST + (16 * t + fr) * 2));
                const float y = acc[rt][ct][r] + dsk * u;
                gout[(size_t)ssm_row(b, j, t) * D + 16 * g + fr] = (bf16)f2bf(clamp16(gelu_tanh_f(y))); } }
    __syncthreads();
}

__device__ __forceinline__ void ssm_build(LAS unsigned char* lds, int g, const float* are, const float* aim, const float* logdt, const float* bre, const float* bim,
                                          const float* cre, const float* cim, bf16* W1t, bf16* W2t) {
    int tid_ = threadIdx.x; asm volatile("" : "+v"(tid_)); const int tid = tid_;
    LAS float* Lp = (LAS float*)lds;
    LAS float* Bb = Lp + 2 * 17 * 64 * 2;
    LAS float* Cc = Bb + 2 * 64 * 16 * 2;
    LAS float* Kk = Cc + 2 * 16 * 64 * 2;
    for (int id = tid; id < 2 * 17 * 64; id += 512) { const int p = id & 63, k = (id >> 6) % 17, dir = id / (17 * 64); const int gp = (dir * 64 + g) * 64 + p;
        const float lre = fminf(are[gp], -1e-4f), lim = aim[gp], dt = expf(logdt[dir * 64 + g]);
        const float mag = expf((float)k * lre * dt), ang = (float)k * lim * dt;
        Lp[id * 2] = mag * cosf(ang); Lp[id * 2 + 1] = mag * sinf(ang); }
    for (int id = tid; id < 2 * 64 * 16; id += 512) { const int c = id & 15, p = (id >> 4) & 63, dir = id >> 10; const int gp = (dir * 64 + g) * 64 + p;
        const float lre = fminf(are[gp], -1e-4f), lim = aim[gp], dt = expf(logdt[dir * 64 + g]);
        const float mag = expf(lre * dt), lbr = mag * cosf(lim * dt), lbi = mag * sinf(lim * dt);
        const float nr = lbr - 1.f, ni = lbi, den = lre * lre + lim * lim;
        const float cfr = (nr * lre + ni * lim) / den, cfi = (ni * lre - nr * lim) / den;
        const float br = bre[(size_t)gp * 16 + c], bi = bim[(size_t)gp * 16 + c];
        Bb[id * 2] = cfr * br - cfi * bi; Bb[id * 2 + 1] = cfr * bi + cfi * br; }
    for (int id = tid; id < 2 * 16 * 64; id += 512) { const int p = id & 63, c = (id >> 6) & 15, dir = id >> 10; const size_t src = ((size_t)(dir * 64 + g) * 16 + c) * 64 + p;
        Cc[id * 2] = cre[src]; Cc[id * 2 + 1] = cim[src]; }
    __syncthreads();
    for (int id = tid; id < 2 * 16 * 256; id += 512) { const int ci = id & 15, co = (id >> 4) & 15, d = (id >> 8) & 15, dir = id >> 12;
        float s = 0.f;
        for (int p = 0; p < 64; ++p) { const int li = ((dir * 17 + d) * 64 + p) * 2, bi_ = ((dir * 64 + p) * 16 + ci) * 2, ci_ = ((dir * 16 + co) * 64 + p) * 2;
            const float lr = Lp[li], lim_ = Lp[li + 1], br = Bb[bi_], bim_ = Bb[bi_ + 1], cr = Cc[ci_], cim_ = Cc[ci_ + 1];
            const float xr = lr * br - lim_ * bim_, xi = lr * bim_ + lim_ * br;
            s += cr * xr - cim_ * xi; }
        Kk[id] = s; }
    __syncthreads();
    for (int id = tid; id < 256 * 256; id += 512) { const int k = id & 255, n = id >> 8; const int s = k >> 4, c = k & 15, dir = n >> 7, part = (n >> 6) & 1, p = n & 63;
        const int e = dir == 0 ? 15 - s : s; const int li = ((dir * 17 + e) * 64 + p) * 2, bi_ = ((dir * 64 + p) * 16 + c) * 2;
        const float lr = Lp[li], lim_ = Lp[li + 1], br = Bb[bi_], bim_ = Bb[bi_ + 1];
        const float v = part == 0 ? lr * br - lim_ * bim_ : lr * bim_ + lim_ * br;
        W1t[id] = (bf16)f2bf(v); }
    for (int id = tid; id < 256 * 512; id += 512) { const int k = id & 511, n = id >> 9; const int t = n >> 4, co = n & 15; float v;
        if (k < 256) { const int s = k >> 4, ci = k & 15; v = 0.f;
            if (s <= t) v += Kk[((0 * 16 + (t - s)) * 16 + co) * 16 + ci];
            if (s >= t) v += Kk[((1 * 16 + (s - t)) * 16 + co) * 16 + ci]; }
        else { const int kk = k - 256, dir = kk >> 7, part = (kk >> 6) & 1, p = kk & 63; const int e = dir == 0 ? t + 1 : 16 - t;
            const int li = ((dir * 17 + e) * 64 + p) * 2, ci_ = ((dir * 16 + co) * 64 + p) * 2;
            const float lr = Lp[li], lim_ = Lp[li + 1], cr = Cc[ci_], cim_ = Cc[ci_ + 1];
            v = part == 0 ? cr * lr - cim_ * lim_ : -(cr * lim_ + cim_ * lr); }
        W2t[id] = (bf16)f2bf(v); }
    __syncthreads();
}
struct Ctx {
    LAS unsigned char* lds; int tid, lane, wave, G, bx, gw, ngw;
    const float* const* in; float* out; unsigned char* ws; unsigned* ctl;
    float* modv; float* h; bf16* xn;
};
__device__ __forceinline__ void load_row_f32(const float* p, int lane, f32x4 (&v)[4]) {
#pragma unroll
    for (int j = 0; j < 4; ++j) v[j] = ((const f32x4*)p)[lane + 64 * j];
}
__device__ __forceinline__ void load_row_bf16(const bf16* p, int lane, f32x4 (&v)[4]) {
#pragma unroll
    for (int j = 0; j < 4; ++j) { const u32x2 w = ((const u32x2*)p)[lane + 64 * j]; v[j] = (f32x4){bflo(w.x), bfhi(w.x), bflo(w.y), bfhi(w.y)}; }
}
__device__ __forceinline__ void store_row_bf16(bf16* p, int lane, const f32x4 (&v)[4]) {
#pragma unroll
    for (int j = 0; j < 4; ++j) { u32x2 w; w.x = pk2(v[j][0], v[j][1]); w.y = pk2(v[j][2], v[j][3]); ((u32x2*)p)[lane + 64 * j] = w; }
}
__device__ __forceinline__ float row_ss(const f32x4 (&v)[4]) {
    float s = 0.f;
#pragma unroll
    for (int j = 0; j < 4; ++j) s += (v[j][0] * v[j][0] + v[j][1] * v[j][1]) + (v[j][2] * v[j][2] + v[j][3] * v[j][3]);
    return wave_sum(s);
}
__device__ __forceinline__ void phase_t1(const Ctx& C, int L, bool pending) {
    const float* x = C.in[0]; const float* cx = C.in[2];
    const bf16* ys = (const bf16*)(C.ws + WS_YS); const int* rslot = (const int*)(C.ws + WS_TAB + TAB_ROUTE_S);
    const int nrows = (L == 4) ? NLAT : NROWS;
    for (int r = C.gw; r < nrows; r += C.ngw) {
        const int mr = mrow_of(r);
        f32x4 v[4];
        if (L == 0) load_row_f32(r < NLAT ? x + (size_t)r * D : cx + (size_t)(r - NLAT) * D, C.lane, v);
        else load_row_f32(C.h + (size_t)r * D, C.lane, v);
        if (L > 0 && pending) {
            const int s1 = rslot[2 * r], s2 = rslot[2 * r + 1];
            f32x4 y1[4], y2[4], g5[4];
            load_row_bf16(ys + (size_t)s1 * D, C.lane, y1); load_row_bf16(ys + (size_t)s2 * D, C.lane, y2);
            load_row_f32(C.modv + ((size_t)(L - 1) * 9 + mr) * 6144 + 5 * 1024, C.lane, g5);
#pragma unroll
            for (int j = 0; j < 4; ++j) v[j] = v[j] + g5[j] * (y1[j] + y2[j]);
        }
        if (L < 4 && (L == 0 || pending)) {
#pragma unroll
            for (int j = 0; j < 4; ++j) ((f32x4*)(C.h + (size_t)r * D))[C.lane + 64 * j] = v[j];
        }
        const float rs = rsqrtf(row_ss(v) * (1.f / D) + 1e-6f);
        if (L == 4) {
            f32x4 g[4]; load_row_f32(C.in[8], C.lane, g);
#pragma unroll
            for (int j = 0; j < 4; ++j) ((f32x4*)(C.out + (size_t)r * D))[C.lane + 64 * j] = v[j] * rs * g[j];
        } else {
            f32x4 g[4], sh[4], sc[4]; load_row_f32(C.in[6] + L * D, C.lane, g);
            const float* ml = C.modv + ((size_t)L * 9 + mr) * 6144; load_row_f32(ml, C.lane, sh); load_row_f32(ml + 1024, C.lane, sc);
            f32x4 o[4];
#pragma unroll
            for (int j = 0; j < 4; ++j) o[j] = v[j] * rs * g[j] * (sc[j] + 1.f) + sh[j];
            store_row_bf16(C.xn + (size_t)r * D, C.lane, o);
#ifdef MK_DEBUG_XN_F32
            { float* dbg = (float*)(C.ws + 3 * MiB);
#pragma unroll
              for (int j = 0; j < 4; ++j) ((f32x4*)(dbg + (size_t)r * D))[C.lane + 64 * j] = o[j]; }
#endif
        }
    }
}
__device__ __forceinline__ void phase_t2(const Ctx& C, int L) {
    const int nrows = (L == 3) ? NLAT : NROWS;
    const float* gw = C.in[28] + (size_t)L * 4096; const float* gb = C.in[29] + L * 4; const float* rw = C.in[30] + (size_t)L * 32768; const float* rb = C.in[31] + L * 32;
    LAS float* rwl = (LAS float*)C.lds;
    for (int i = C.tid; i < 8192; i += 512) ((LAS f32x4*)rwl)[i] = ((const f32x4*)rw)[i];
    f32x4 gwr[4][4];
#pragma unroll
    for (int j = 0; j < 4; ++j)
#pragma unroll
        for (int e = 0; e < 4; ++e) gwr[j][e] = ((const f32x4*)gw)[4 * C.lane + 256 * j + e];
    __syncthreads();
    int* ri = (int*)(C.ws + WS_TAB + TAB_ROUTE_I); float* rwt = (float*)(C.ws + WS_TAB + TAB_ROUTE_W);
    unsigned* cnt = C.ctl + CW_CNT + L * 32 * 64;
    for (int r = C.gw; r < nrows; r += C.ngw) {
        const int mr = mrow_of(r);
        f32x4 v[4]; load_row_f32(C.h + (size_t)r * D, C.lane, v);
        const float rs = rsqrtf(row_ss(v) * (1.f / D) + 1e-6f);
        f32x4 g[4], sh[4], sc[4]; load_row_f32(C.in[7] + L * D, C.lane, g);
        const float* ml = C.modv + ((size_t)L * 9 + mr) * 6144; load_row_f32(ml + 3 * 1024, C.lane, sh); load_row_f32(ml + 4 * 1024, C.lane, sc);
        f32x4 xm[4];
#pragma unroll
        for (int j = 0; j < 4; ++j) xm[j] = v[j] * rs * g[j] * (sc[j] + 1.f) + sh[j];
        store_row_bf16(C.xn + (size_t)r * D, C.lane, xm);
        f32x4 gl = {0.f, 0.f, 0.f, 0.f};
#pragma unroll
        for (int j = 0; j < 4; ++j)
#pragma unroll
            for (int e = 0; e < 4; ++e) gl = gl + gwr[j][e] * xm[j][e];
        float g0 = wave_sum(gl[0]) + gb[0], g1 = wave_sum(gl[1]) + gb[1], g2 = wave_sum(gl[2]) + gb[2], g3 = wave_sum(gl[3]) + gb[3];
        int gi = 0; float gm = g0;
        if (g1 > gm) { gm = g1; gi = 1; } if (g2 > gm) { gm = g2; gi = 2; } if (g3 > gm) { gm = g3; gi = 3; }
        const float pg = 1.f / (__expf(g0 - gm) + __expf(g1 - gm) + __expf(g2 - gm) + __expf(g3 - gm));
        f32x4 ea = {0.f, 0.f, 0.f, 0.f}, eb = {0.f, 0.f, 0.f, 0.f};
        const LAS float* rp = rwl + (size_t)gi * 8192;
#pragma unroll
        for (int j = 0; j < 4; ++j)
#pragma unroll
            for (int e = 0; e < 4; ++e) { const int col = 4 * C.lane + 256 * j + e; const f32x4 w0 = *(const LAS f32x4*)(rp + col * 8), w1 = *(const LAS f32x4*)(rp + col * 8 + 4);
                ea = ea + w0 * xm[j][e]; eb = eb + w1 * xm[j][e]; }
        float el[8];
#pragma unroll
        for (int e = 0; e < 4; ++e) { el[e] = wave_sum(ea[e]) + rb[gi * 8 + e]; el[4 + e] = wave_sum(eb[e]) + rb[gi * 8 + 4 + e]; }
        int e1 = 0; float v1 = el[0];
#pragma unroll
        for (int e = 1; e < 8; ++e) if (el[e] > v1) { v1 = el[e]; e1 = e; }
        int e2 = -1; float v2 = -3.4e38f;
#pragma unroll
        for (int e = 0; e < 8; ++e) if (e != e1 && el[e] > v2) { v2 = el[e]; e2 = e; }
        const float ex = __expf(v2 - v1); const float w1 = pg / (1.f + ex), w2 = pg * ex / (1.f + ex);
        if (C.lane == 0) {
            const int ge1 = gi * 8 + e1, ge2 = gi * 8 + e2;
            const unsigned p1 = atomicAdd(cnt + ge1 * 64, 1u), p2 = atomicAdd(cnt + ge2 * 64, 1u);
            ri[4 * r] = ge1; ri[4 * r + 1] = (int)p1; ri[4 * r + 2] = ge2; ri[4 * r + 3] = (int)p2; rwt[2 * r] = w1; rwt[2 * r + 1] = w2;
        }
    }
    __syncthreads();
}
__device__ __forceinline__ void phase_t3(const Ctx& C, int L) {
    const int nrows = (L == 3) ? NLAT : NROWS;
    LAS int* toff = (LAS int*)C.lds;
    unsigned* cnt = C.ctl + CW_CNT + L * 32 * 64; unsigned* tbl = C.ctl + CW_TILE + L * 256;
    if (C.tid == 0) { int acc = 0; for (int e = 0; e < 32; ++e) { toff[e] = acc; acc += ((int)ld_agent(cnt + e * 64) + 255) >> 8; } toff[32] = acc; }
    __syncthreads();
    if (C.bx == 0) {
        if (C.tid == 0) tbl[0] = (unsigned)toff[32];
        if (C.tid < 32) { for (int t = toff[C.tid]; t < toff[C.tid + 1]; ++t) tbl[1 + t] = (unsigned)C.tid; }
    }
    const int* ri = (const int*)(C.ws + WS_TAB + TAB_ROUTE_I); const float* rwt = (const float*)(C.ws + WS_TAB + TAB_ROUTE_W);
    int* rslot = (int*)(C.ws + WS_TAB + TAB_ROUTE_S); float* wslot = (float*)(C.ws + WS_TAB + TAB_WSLOT);
    bf16* xs = (bf16*)(C.ws + WS_XS);
    for (int r = C.gw; r < nrows; r += C.ngw) {
        const int e1 = ri[4 * r], p1 = ri[4 * r + 1], e2 = ri[4 * r + 2], p2 = ri[4 * r + 3];
        const int s1 = toff[e1] * 256 + p1, s2 = toff[e2] * 256 + p2;
        u32x2 w[4];
#pragma unroll
        for (int j = 0; j < 4; ++j) w[j] = ((const u32x2*)(C.xn + (size_t)r * D))[C.lane + 64 * j];
#pragma unroll
        for (int j = 0; j < 4; ++j) { ((u32x2*)(xs + (size_t)s1 * D))[C.lane + 64 * j] = w[j]; ((u32x2*)(xs + (size_t)s2 * D))[C.lane + 64 * j] = w[j]; }
        if (C.lane == 0) { rslot[2 * r] = s1; rslot[2 * r + 1] = s2; wslot[s1] = rwt[2 * r]; wslot[s2] = rwt[2 * r + 1]; }
    }
    __syncthreads();
}
__device__ __forceinline__ void phase_diffcombine(const Ctx& C, int i, float lambda_init) {
    const float* lq1 = C.in[13] + i * 64; const float* lk1 = C.in[14] + i * 64; const float* lq2 = C.in[15] + i * 64; const float* lk2 = C.in[16] + i * 64; const float* subg = C.in[17] + i * 128;
    const float lam = __expf(wave_sum(lq1[C.lane] * lk1[C.lane])) - __expf(wave_sum(lq2[C.lane] * lk2[C.lane])) + lambda_init;
    const float* o12 = (const float*)(C.ws + WS_O12); bf16* merged = (bf16*)(C.ws + WS_MERGED);
    const f32x2 sg = *(const f32x2*)(subg + 2 * C.lane);
    for (int r = C.gw; r < NROWS; r += C.ngw) {
#pragma unroll
        for (int hd = 0; hd < 4; ++hd) {
            const f32x2 a = *(const f32x2*)(o12 + (size_t)r * D + hd * 256 + 2 * C.lane), bq = *(const f32x2*)(o12 + (size_t)r * D + hd * 256 + 128 + 2 * C.lane);
            const f32x2 ob = a - bq * lam;
            const float rs = rsqrtf(wave_sum(ob[0] * ob[0] + ob[1] * ob[1]) * (1.f / 128.f) + 1e-6f) * (1.f - lambda_init);
            *(unsigned*)(merged + (size_t)r * D + 512 + hd * 128 + 2 * C.lane) = pk2(ob[0] * rs * sg[0], ob[1] * rs * sg[1]);
        }
    }
}

__device__ __forceinline__ void p0_mod(const Ctx& C) {
    LAS float* sil = (LAS float*)C.lds;
    LAS float* red = sil + 9 * 1024;
    for (int i = C.tid; i < 9 * 1024; i += 512) { const int r = i >> 10, k = i & 1023; const float v = r < 8 ? C.in[1][r * 1024 + k] : C.in[3][k]; sil[i] = v / (1.f + __expf(-v)); }
    __syncthreads();
    for (int it = C.bx; it < 4 * 96; it += C.G) {
        const int l = it / 96, j0 = (it % 96) * 64;
        const float* w = C.in[4] + ((size_t)l * 1024 + C.wave * 128) * 6144 + j0 + C.lane;
        float a[9];
#pragma unroll
        for (int r = 0; r < 9; ++r) a[r] = 0.f;
#pragma unroll 8
        for (int k = 0; k < 128; ++k) { const float wv = w[(size_t)k * 6144];
#pragma unroll
            for (int r = 0; r < 9; ++r) a[r] += sil[r * 1024 + C.wave * 128 + k] * wv; }
#pragma unroll
        for (int r = 0; r < 9; ++r) red[(C.wave * 9 + r) * 64 + C.lane] = a[r];
        __syncthreads();
        for (int o = C.tid; o < 9 * 64; o += 512) { const int r = o >> 6, c = o & 63; float s = 0.f;
#pragma unroll
            for (int wv = 0; wv < 8; ++wv) s += red[(wv * 9 + r) * 64 + c];
            C.modv[((size_t)l * 9 + r) * 6144 + j0 + c] = s + C.in[5][l * 6144 + j0 + c]; }
        __syncthreads();
    }
}
template <class RowMap>
__device__ __forceinline__ void p0_transpose_item(const float* W, int K, int N, bf16* WT, const RowMap& rm, LAS float* scr, int item, int lane) {
    const int nblk = N / 32, kb = item / nblk, nb = item % nblk, k0 = 64 * kb, n0 = 32 * nb;
#pragma unroll 8
    for (int i = 0; i < 32; ++i) { const int kk = 2 * i + (lane >> 5); scr[kk * 33 + (lane & 31)] = W[(size_t)(k0 + kk) * N + n0 + (lane & 31)]; }
    asm volatile("s_waitcnt lgkmcnt(0)" ::: "memory");
    const int c = lane & 7;
#pragma unroll
    for (int j = 0; j < 4; ++j) { const int n = (lane >> 3) + 8 * j; const LAS float* s = scr + (8 * c) * 33 + n;
        u32x4 o; o.x = pk2(s[0 * 33], s[1 * 33]); o.y = pk2(s[2 * 33], s[3 * 33]); o.z = pk2(s[4 * 33], s[5 * 33]); o.w = pk2(s[6 * 33], s[7 * 33]);
        *(u32x4*)(WT + (size_t)rm(n0 + n) * K + k0 + 8 * c) = o; }
    asm volatile("s_waitcnt lgkmcnt(0)" ::: "memory");
}
struct MapId { int off; __device__ __forceinline__ int operator()(int n) const { return off + n; } };
struct MapQKV { __device__ __forceinline__ int operator()(int n) const { const int hs = n >> 6, d = n & 63; const int bj = d >> 5, dd = d & 31, ni = dd >> 4, fq = (dd & 15) >> 2, j = dd & 3;
    return 256 * (hs >> 2) + 128 * bj + 32 * (hs & 3) + 8 * fq + 4 * ni + j; } };
struct MapIlv { int base, which; __device__ __forceinline__ int operator()(int o) const {
    return base + 256 * (o >> 7) + 128 * ((o & 127) >> 6) + 32 * ((o & 63) >> 4) + 8 * ((o & 15) >> 2) + 4 * which + (o & 3); } };

__device__ __forceinline__ void p0_convert(const Ctx& C) {
    LAS float* scr = (LAS float*)(C.lds + C.wave * 16384);
    bf16* Wqkv = (bf16*)(C.ws + WS_WQKV); bf16* Wo = (bf16*)(C.ws + WS_WO); bf16* Wglu = (bf16*)(C.ws + WS_WGLU); bf16* Wgu = (bf16*)(C.ws + WS_WGU); bf16* Wd = (bf16*)(C.ws + WS_WD);
    constexpr int I_QKV = 16 * 72, I_SQ = 16 * 32, I_G = 16 * 8, I_DN = 4 * 32;
    constexpr int N0 = 2 * I_QKV, N1 = N0 + 2 * I_SQ, N2 = N1 + 4 * I_SQ, N3 = N2 + 256 * I_G, N4 = N3 + 128 * I_DN;
    for (int it = C.gw; it < N4; it += C.ngw) {
        if (it < N0) { const int i = it / I_QKV, r = it % I_QKV; p0_transpose_item(C.in[9] + (size_t)i * D * 2304, D, 2304, Wqkv + (size_t)i * 2304 * D, MapQKV{}, scr, r, C.lane); }
        else if (it < N1) { const int q = it - N0, i = q / I_SQ, r = q % I_SQ; p0_transpose_item(C.in[10] + (size_t)i * D * D, D, D, Wo + (size_t)i * D * D, MapId{0}, scr, r, C.lane); }
        else if (it < N2) { const int q = it - N1, mi = q / I_SQ, r = q % I_SQ, i = mi >> 1, wh = mi & 1;
            p0_transpose_item((wh ? C.in[27] : C.in[26]) + (size_t)i * D * D, D, D, Wglu + (size_t)i * 2048 * D, MapIlv{0, wh}, scr, r, C.lane); }
        else if (it < N3) { const int q = it - N2, mi = q / I_G, r = q % I_G, wh = mi & 1, le = mi >> 1;
            p0_transpose_item((wh ? C.in[33] : C.in[32]) + (size_t)le * D * 256, D, 256, Wgu + (size_t)le * 512 * D, MapIlv{0, wh}, scr, r, C.lane); }
        else { const int q = it - N3, le = q / I_DN, r = q % I_DN;
            p0_transpose_item(C.in[34] + (size_t)le * 256 * D, 256, D, Wd + (size_t)le * D * 256, MapId{0}, scr, r, C.lane); }
    }
}
__device__ __forceinline__ void p0_misc(const Ctx& C) {
    if (C.bx == C.G - 1) {
        float* tab = (float*)(C.ws + WS_TAB);
        for (int i = C.tid; i < 1024; i += 512) { const int pos = i >> 4, f = i & 15; const float inv = powf(10000.f, -(float)f / 16.f); const float ang = (float)pos * inv;
            tab[2 * i] = cosf(ang); tab[2 * i + 1] = sinf(ang); }
    }
    __syncthreads();
    for (int u = C.bx; u < 128; u += C.G) { const int i = u >> 6, g = u & 63;
        ssm_build(C.lds, g, C.in[18] + (size_t)i * 8192, C.in[19] + (size_t)i * 8192, C.in[20] + i * 128, C.in[21] + (size_t)i * 131072, C.in[22] + (size_t)i * 131072,
                  C.in[23] + (size_t)i * 131072, C.in[24] + (size_t)i * 131072,
                  (bf16*)(C.ws + WS_SSM) + ((size_t)i * 64 + g) * 65536, (bf16*)(C.ws + WS_SSM + 16 * MiB) + ((size_t)i * 64 + g) * 131072); }
}
constexpr int N_PHASES = 42;
struct Args { const float* in[35]; float* out; unsigned char* ws; int ph_lo, ph_hi, use_bar, pending; };
static_assert(sizeof(Args) == 35 * 8 + 8 + 8 + 16, "Args has no padding");

__device__ __forceinline__ Ctx make_ctx(const Args& a, unsigned char* lds_raw) {
    Ctx C;
    C.lds = (LAS unsigned char*)lds_raw;
    int tid_ = threadIdx.x; asm volatile("" : "+v"(tid_));
    C.tid = tid_; C.lane = C.tid & 63; C.wave = __builtin_amdgcn_readfirstlane(C.tid >> 6);
    int bx_ = blockIdx.x; asm volatile("" : "+s"(bx_));
    C.G = gridDim.x; C.bx = bx_; C.gw = bx_ * 8 + C.wave; C.ngw = C.G * 8;
    unsigned long long w = (unsigned long long)a.ws, o = (unsigned long long)a.out;
    asm volatile("" : "+s"(w), "+s"(o));
    C.in = a.in; C.out = (float*)o; C.ws = (unsigned char*)w; C.ctl = (unsigned*)(C.ws + WS_CTL);
    C.modv = (float*)(C.ws + WS_MODV); C.h = (float*)(C.ws + WS_H); C.xn = (bf16*)(C.ws + WS_XN);
    return C;
}
#define PHASE_CTX() C = make_ctx(a, lds_raw); ws = C.ws; bx = C.bx; Qb = (bf16*)(ws + WS_Q); Kb = (bf16*)(ws + WS_K); Vb = (bf16*)(ws + WS_V); merged = (bf16*)(ws + WS_MERGED); o12 = (float*)(ws + WS_O12)
__global__ void __launch_bounds__(512, 2) mk_fwd(Args a) {
    extern __shared__ __attribute__((aligned(16))) unsigned char lds_raw[];
    Ctx C = make_ctx(a, lds_raw);
    if (C.tid < 64) ((LAS unsigned*)(C.lds + LDS_BARW))[C.tid] = 0u;
    __syncthreads();
    XcdBarrier bar; bar.bar = C.ctl + CW_BAR; bar.x = 0; bar.st = (volatile LAS unsigned*)(C.lds + LDS_BARW);
    if (a.use_bar) { bar = xcd_barrier_post(C.ctl + CW_BAR, (volatile LAS unsigned*)(C.lds + LDS_BARW)); xcd_barrier<true>(bar); }
    const int lo = a.ph_lo, hi = a.ph_hi;
#define IN(k) (lo <= (k) && (k) < hi)
#define SEAM() do { if (a.use_bar) { XcdBarrier bl_ = bar; asm volatile("" : "+s"(bl_.x)); xcd_barrier<false>(bl_); } } while (0)
    int bx;
    unsigned char* ws; bf16 *Qb, *Kb, *Vb, *merged; float* o12;

    if (IN(0)) { PHASE_CTX(); p0_mod(C); p0_convert(C); p0_misc(C); SEAM(); }

    for (int L = 0; L < 4; ++L) {
        const int pb = 1 + 10 * L, i = L >> 1;
        if (IN(pb)) { PHASE_CTX(); phase_t1(C, L, a.pending != 0 || lo < pb); SEAM(); }
        if ((L & 1) == 0) {
            if (IN(pb + 1)) { PHASE_CTX();
                pg8::Gemm g{C.xn, (const bf16*)(ws + WS_WQKV) + (size_t)i * 2304 * D, NROWS, 2304, D}; pg8::StaticOrder S; S.init(NROWS, 2304, C.G, bx);
                EpiQKV E{Qb, Kb, Vb, C.in[11] + i * 64, C.in[12] + i * 64, (const float*)(ws + WS_TAB)};
                pg8::gemm_phase<EpiQKV, pg8::StaticOrder, true, true>(C.lds, g, S, E);
                SEAM();
            }
            if (IN(pb + 2)) { PHASE_CTX();
                for (int ui = bx; ui < 1152; ui += C.G) {
                    int b, qrow0, qcol, kcol, vcol, ocol; bool lat, vd64;
                    if (ui < 512) { const int vh = ui & 7, qb = (ui >> 3) & 7; b = ui >> 6; lat = true; vd64 = true; qrow0 = b * 2048 + qb * 256; qcol = 64 * vh; kcol = 64 * (vh >> 2); vcol = kcol; ocol = 64 * vh; }
                    else if (ui < 1024) { const int u2 = ui - 512, v8 = u2 & 7, qb = (u2 >> 3) & 7; b = u2 >> 6; lat = true; vd64 = false; qrow0 = b * 2048 + qb * 256; qcol = 512 + 64 * v8; kcol = 128 + 64 * v8; vcol = 128 + 128 * (v8 >> 1); ocol = 128 * v8; }
                    else { const int u3 = ui - 1024, vh = u3 & 15; b = u3 >> 4; lat = false; qrow0 = NLAT + b * 256;
                        if (vh < 8) { vd64 = true; qcol = 64 * vh; kcol = 64 * (vh >> 2); vcol = kcol; ocol = 64 * vh; }
                        else { const int v8 = vh - 8; vd64 = false; qcol = 512 + 64 * v8; kcol = 128 + 64 * v8; vcol = 128 + 128 * (v8 >> 1); ocol = 128 * v8; } }
                    if (vd64) attn_unit<64>(C.lds, Qb, Kb, Vb, merged, o12, b, qrow0, lat, qcol, kcol, vcol, ocol);
                    else attn_unit<128>(C.lds, Qb, Kb, Vb, merged, o12, b, qrow0, lat, qcol, kcol, vcol, ocol);
                }
                SEAM();
            }
            if (IN(pb + 3)) { PHASE_CTX(); phase_diffcombine(C, i, L == 0 ? 0.2f : 0.47071303f);     SEAM(); }
            if (IN(pb + 4)) { PHASE_CTX();
                pg8::Gemm g{merged, (const bf16*)(ws + WS_WO) + (size_t)i * D * D, NROWS, D, D}; pg8::StaticOrder S; S.init(NROWS, D, C.G, bx);
                EpiResid E{C.h, C.modv + (size_t)L * 9 * 6144 + 2 * 1024};
                pg8::gemm_phase<EpiResid, pg8::StaticOrder, true, true>(C.lds, g, S, E);
                SEAM();
            }
        } else {
            if (IN(pb + 1)) { PHASE_CTX();
                for (int u = bx; u < 512; u += C.G) { const int g = u >> 3, b = u & 7;
                    ssm_unit(C.lds, b, g, C.xn, merged, (const bf16*)(ws + WS_SSM) + ((size_t)i * 64 + g) * 65536, (const bf16*)(ws + WS_SSM + 16 * MiB) + ((size_t)i * 64 + g) * 131072,
                             C.in[18] + (size_t)i * 8192, C.in[19] + (size_t)i * 8192, C.in[20] + i * 128, C.in[25] + i * D); }
                SEAM();
            }
            if (IN(pb + 4)) { PHASE_CTX();
                const int M = (L == 3) ? NLAT : NROWS;
                pg8::Gemm g{merged, (const bf16*)(ws + WS_WGLU) + (size_t)i * 2048 * D, M, 2048, D}; pg8::StaticOrder S; S.init(M, 2048, C.G, bx);
                EpiGLU E{C.h, C.modv + (size_t)L * 9 * 6144 + 2 * 1024};
                pg8::gemm_phase<EpiGLU, pg8::StaticOrder, true, true>(C.lds, g, S, E);
                SEAM();
            }
        }
        if (IN(pb + 5)) { PHASE_CTX(); phase_t2(C, L); SEAM(); }
        if (IN(pb + 6)) { PHASE_CTX(); phase_t3(C, L); SEAM(); }
        if (IN(pb + 7)) { PHASE_CTX();
            pg8::Gemm g{(const bf16*)(ws + WS_XS), (const bf16*)(ws + WS_WGU) + (size_t)L * 32 * 512 * D, 0, 0, D}; MoeOrder S{C.ctl + CW_TILE + L * 256, 2, C.G, bx};
            EpiGateUp E{(bf16*)(ws + WS_HID), (const float*)(ws + WS_TAB + TAB_WSLOT)};
            pg8::gemm_phase<EpiGateUp, MoeOrder, true, true>(C.lds, g, S, E);
            SEAM();
        }
        if (IN(pb + 8)) { PHASE_CTX(); int kdown = 256; asm volatile("" : "+s"(kdown));
            pg8::Gemm g{(const bf16*)(ws + WS_HID), (const bf16*)(ws + WS_WD) + (size_t)L * 32 * D * 256, 0, 0, kdown}; MoeOrder S{C.ctl + CW_TILE + L * 256, 4, C.G, bx};
            EpiDown E{(bf16*)(ws + WS_YS)};
            pg8::gemm_phase<EpiDown, MoeOrder, true, true>(C.lds, g, S, E);
            SEAM();
        }
    }
    if (IN(41)) { PHASE_CTX(); phase_t1(C, 4, true); }
#undef IN
#undef SEAM
}

static bool phase_exists(int p) {
    if (p == 0 || p == 41) return true;
    const int L = (p - 1) / 10, k = (p - 1) % 10;
    if (k == 9) return false;
    if ((L & 1) && (k == 2 || k == 3)) return false;
    return true;
}
static void mk_run(void* const* d_in, float* out, unsigned char* ws, hipStream_t stream, int lo, int hi, bool one_launch, int pending) {
    static int grid = 0;
    if (grid == 0) {
        int dev = 0, cus = 0, per_cu = 0;
        if (hipGetDevice(&dev) != hipSuccess || hipDeviceGetAttribute(&cus, hipDeviceAttributeMultiprocessorCount, dev) != hipSuccess) { grid = -1; return; }
        if (hipFuncSetAttribute((const void*)mk_fwd, hipFuncAttributeMaxDynamicSharedMemorySize, LDS_BYTES) != hipSuccess) { fprintf(stderr, "mk: hipFuncSetAttribute failed\n"); grid = -1; return; }
        if (hipOccupancyMaxActiveBlocksPerMultiprocessor(&per_cu, (const void*)mk_fwd, 512, LDS_BYTES) != hipSuccess || per_cu < 1) { fprintf(stderr, "mk: occupancy query says %d\n", per_cu); }
        (void)hipGetLastError();
        grid = cus;
    }
    if (grid < 0) return;
    Args a{};
    for (int i = 0; i < 35; ++i) a.in[i] = (const float*)d_in[i];
    a.out = out; a.ws = ws; a.pending = pending;
    if (one_launch) { a.ph_lo = lo; a.ph_hi = hi; a.use_bar = 1; hipLaunchKernelGGL(mk_fwd, dim3(grid), dim3(512), LDS_BYTES, stream, a); }
    else for (int p = lo; p < hi; ++p) if (phase_exists(p)) { a.ph_lo = p; a.ph_hi = p + 1; a.use_bar = 0; hipLaunchKernelGGL(mk_fwd, dim3(grid), dim3(512), LDS_BYTES, stream, a); }
}
#ifndef MK_ONE_LAUNCH
#define MK_ONE_LAUNCH 1
#endif
extern "C" void kernel_launch(void* const* d_in, const int* in_sizes, int n_in, void* d_out, int out_size, void* d_ws, size_t ws_size, hipStream_t stream) {
    if (n_in != 35 || ws_size < WS_END || out_size != NLAT * D) { fprintf(stderr, "kernel_launch: unexpected n_in %d / ws %zu / out %d\n", n_in, ws_size, out_size); return; }
    unsigned char* ws = (unsigned char*)d_ws;
    (void)hipMemsetAsync(ws + WS_CTL, 0, CTL_ZERO_BYTES, stream);
    mk_run(d_in, (float*)d_out, ws, stream, 0, N_PHASES, MK_ONE_LAUNCH != 0, 1);
}
```
